# Optimizing an MI355X kernel written in HIP

```python
import math
import jax, jax.numpy as jnp
from jax import lax
import numpy as np

D_MODEL = 1024
BATCH = 8
SEQ = 4096
DEPTH = 2

EPS = 1e-6
BLOCK_Q = 128
D_FF = 2816
GLA_HEADS = 4
GLA_DK = 64
GLA_DV = 128
GLA_GATE_RANK = 16
GLA_GATE_NORMALIZER = 16.0
GLA_CHUNK = 64
FOX_HEADS = 8
FOX_DH = 64
DSA_HEADS = 16
DSA_DH = 64
DSA_LATENT = 256
IDX_HEADS = 8
IDX_DIM = 64
TOPK_MAX = 256
T5_BUCKETS = 32
T5_MAX_DIST = 128

N_EVEN = (DEPTH + 1) // 2
N_ODD = DEPTH // 2

EVEN_SIZES = (GLA_HEADS * GLA_DK, GLA_HEADS * GLA_DK, GLA_HEADS * GLA_DV, GLA_HEADS * GLA_DV, GLA_GATE_RANK,
              FOX_HEADS * FOX_DH, FOX_HEADS * FOX_DH, FOX_HEADS * FOX_DH, FOX_HEADS)
ODD_SIZES = (DSA_HEADS * DSA_DH, DSA_LATENT, IDX_HEADS * IDX_DIM, IDX_DIM, IDX_HEADS)
D_IN_EVEN = sum(EVEN_SIZES)
D_IN_ODD = sum(ODD_SIZES)
EVEN_SPLITS = tuple(int(v) for v in np.cumsum(EVEN_SIZES)[:-1])
ODD_SPLITS = tuple(int(v) for v in np.cumsum(ODD_SIZES)[:-1])
D_MIX_EVEN = GLA_HEADS * GLA_DV + FOX_HEADS * FOX_DH
D_MIX_ODD = DSA_HEADS * DSA_DH

kernel_name = "hybrid_gla_fox_dsa_macaron"


def rmsnorm(x, g):
    xf = x.astype(jnp.float32)
    y = xf * lax.rsqrt(jnp.mean(xf * xf, axis=-1, keepdims=True) + EPS)
    return (y * g.astype(jnp.float32)).astype(x.dtype)


def swiglu(h, w_in, w_out):
    a, b = jnp.split(h @ w_in, 2, axis=-1)
    return (jax.nn.silu(a) * b) @ w_out


def to_blocks(t, nb):
    return t.reshape((t.shape[0], nb, BLOCK_Q) + t.shape[2:]).swapaxes(0, 1)


def gla_chunked(q, k, v, gk):
    B, S, H, dk = q.shape
    dv = v.shape[-1]
    C = GLA_CHUNK
    N = S // C

    def chunks(t):
        return t.astype(jnp.float32).reshape(B, N, C, H, t.shape[-1]).transpose(1, 0, 3, 2, 4)

    qc = chunks(q) * (dk ** -0.5)
    kc, vc, gc = chunks(k), chunks(v), chunks(gk)
    G = jnp.cumsum(gc, axis=-2)
    G_last = G[..., -1, :]
    q_dec = qc * jnp.exp(G)
    k_dec = kc * jnp.exp(-G)
    k_to_end = kc * jnp.exp(G_last[..., None, :] - G)
    causal = jnp.tril(jnp.ones((C, C), dtype=bool))
    A = jnp.where(causal, jnp.einsum('nbhid,nbhjd->nbhij', q_dec, k_dec), 0.0)
    o_intra = jnp.einsum('nbhij,nbhjv->nbhiv', A, vc)

    def step(state, inp):
        qd, ke, vv, gl = inp
        o = jnp.einsum('bhid,bhdv->bhiv', qd, state)
        state = jnp.exp(gl)[..., None] * state + jnp.einsum('bhjd,bhjv->bhdv', ke, vv)
        return state, o

    state0 = jnp.zeros((B, H, dk, dv), jnp.float32)
    _, o_inter = lax.scan(step, state0, (q_dec, k_to_end, vc, G_last))
    o = o_intra + o_inter
    return o.transpose(1, 0, 3, 2, 4).reshape(B, S, H, dv)


def fox_attention(q, k, v, log_f):
    B, S, H, dh = q.shape
    nb = S // BLOCK_Q
    F = jnp.cumsum(log_f, axis=1)
    F_keys = F.transpose(0, 2, 1)
    key_pos = jnp.arange(S)

    def one_block(args):
        i, qb, Fb = args
        q_pos = i * BLOCK_Q + jnp.arange(BLOCK_Q)
        s = jnp.einsum('bqhd,bkhd->bhqk', qb, k).astype(jnp.float32) * (dh ** -0.5)
        s = s + (Fb.transpose(0, 2, 1)[..., :, None] - F_keys[..., None, :])
        s = jnp.where(key_pos[None, :] <= q_pos[:, None], s, -jnp.inf)
        p = jax.nn.softmax(s, axis=-1)
        return jnp.einsum('bhqk,bkhd->bqhd', p.astype(v.dtype), v)

    o = lax.map(one_block, (jnp.arange(nb), to_blocks(q, nb), to_blocks(F, nb)))
    return o.swapaxes(0, 1).reshape(B, S, H, dh)


def t5_bucket(dist):
    max_exact = T5_BUCKETS // 2
    d = jnp.maximum(dist, 1).astype(jnp.float32)
    large = max_exact + (jnp.log(d / max_exact) / math.log(T5_MAX_DIST / max_exact)
                         * (T5_BUCKETS - max_exact)).astype(jnp.int32)
    large = jnp.minimum(large, T5_BUCKETS - 1)
    return jnp.where(dist < max_exact, dist, large)


def dsa_attention(q_lat, c, q_idx, k_idx, w_idx, t5_table):
    B, S, H, DL = q_lat.shape
    k_top = min(TOPK_MAX, S // 4)
    nb = S // BLOCK_Q
    key_pos = jnp.arange(S)
    w_scaled = w_idx.astype(jnp.float32) * (IDX_HEADS ** -0.5)
    gather = jax.vmap(lambda cb, ib: cb[ib])

    def one_block(args):
        i, qb, qib, wb = args
        q_pos = i * BLOCK_Q + jnp.arange(BLOCK_Q)
        logit_idx = jnp.einsum('bqhd,bkd->bqhk', qib, k_idx).astype(jnp.float32) * (IDX_DIM ** -0.5)
        score = jnp.einsum('bqh,bqhk->bqk', wb, jax.nn.relu(logit_idx))
        score = jnp.where((key_pos[None, :] <= q_pos[:, None])[None], score, -jnp.inf)
        _, idx = lax.top_k(score, k_top)
        c_sel = gather(c, idx)
        dist = q_pos[None, :, None] - idx
        bias = t5_table[t5_bucket(jnp.maximum(dist, 0))]
        s = jnp.einsum('bqhl,bqkl->bqhk', qb, c_sel).astype(jnp.float32) * (DSA_DH ** -0.5)
        s = s + bias.transpose(0, 1, 3, 2).astype(jnp.float32)
        s = jnp.where((dist >= 0)[:, :, None, :], s, -jnp.inf)
        p = jax.nn.softmax(s, axis=-1)
        return jnp.einsum('bqhk,bqkl->bqhl', p.astype(c.dtype), c_sel)

    o = lax.map(one_block, (jnp.arange(nb), to_blocks(q_lat, nb), to_blocks(q_idx, nb), to_blocks(w_scaled, nb)))
    return o.swapaxes(0, 1).reshape(B, S, H, DL)


def even_mixer(h, w_in, gla_w_gate, gla_b_gate, gla_norm_g, fox_b_f, w_out):
    B, S, _ = h.shape
    q_g, k_g, v_g, g_out, gk_low, q_f, k_f, v_f, f_logit = jnp.split(h @ w_in, EVEN_SPLITS, axis=-1)
    gk = jax.nn.log_sigmoid((gk_low @ gla_w_gate + gla_b_gate).astype(jnp.float32)) / GLA_GATE_NORMALIZER
    o_gla = gla_chunked(q_g.reshape(B, S, GLA_HEADS, GLA_DK), k_g.reshape(B, S, GLA_HEADS, GLA_DK),
                        v_g.reshape(B, S, GLA_HEADS, GLA_DV), gk.reshape(B, S, GLA_HEADS, GLA_DK)).astype(h.dtype)
    o_gla = rmsnorm(o_gla, gla_norm_g) * jax.nn.silu(g_out.reshape(B, S, GLA_HEADS, GLA_DV))
    log_f = jax.nn.log_sigmoid((f_logit + fox_b_f).astype(jnp.float32))
    o_fox = fox_attention(q_f.reshape(B, S, FOX_HEADS, FOX_DH), k_f.reshape(B, S, FOX_HEADS, FOX_DH),
                          v_f.reshape(B, S, FOX_HEADS, FOX_DH), log_f)
    o = jnp.concatenate([o_gla.reshape(B, S, -1), o_fox.reshape(B, S, -1)], axis=-1)
    return o @ w_out


def odd_mixer(h, w_in, kv_norm_g, w_uk, w_uv, w_out, t5_table):
    B, S, _ = h.shape
    q, ckv, q_idx, k_idx, w_idx = jnp.split(h @ w_in, ODD_SPLITS, axis=-1)
    c = rmsnorm(ckv, kv_norm_g)
    q_lat = jnp.einsum('bshd,hdl->bshl', q.reshape(B, S, DSA_HEADS, DSA_DH), w_uk)
    o_lat = dsa_attention(q_lat, c, q_idx.reshape(B, S, IDX_HEADS, IDX_DIM), k_idx, w_idx, t5_table)
    o = jnp.einsum('bshl,hld->bshd', o_lat, w_uv).reshape(B, S, D_MIX_ODD)
    return o @ w_out


def setup_inputs(seed: int = 0) -> dict:
    key = jax.random.key(seed)
    ks = jax.random.split(key, 17)
    f32 = jnp.float32

    def nrm(k, shape, fan_in):
        return jax.random.normal(k, shape, f32) * (fan_in ** -0.5)

    def gain(k, shape):
        return 1.0 + 0.02 * jax.random.normal(k, shape, f32)

    return {
        "x": jax.random.normal(ks[0], (BATCH, SEQ, D_MODEL), f32),
        "norm_g": gain(ks[1], (DEPTH, 3, D_MODEL)),
        "ffn_w_in": nrm(ks[2], (DEPTH, 2, D_MODEL, 2 * D_FF), D_MODEL),
        "ffn_w_out": nrm(ks[3], (DEPTH, 2, D_FF, D_MODEL), D_FF),
        "even_w_in": nrm(ks[4], (N_EVEN, D_MODEL, D_IN_EVEN), D_MODEL),
        "gla_w_gate": nrm(ks[5], (N_EVEN, GLA_GATE_RANK, GLA_HEADS * GLA_DK), GLA_GATE_RANK),
        "gla_b_gate": 0.02 * jax.random.normal(ks[6], (N_EVEN, GLA_HEADS * GLA_DK), f32),
        "gla_norm_g": gain(ks[7], (N_EVEN, GLA_DV)),
        "fox_b_f": 2.0 + 0.5 * jax.random.normal(ks[8], (N_EVEN, FOX_HEADS), f32),
        "even_w_out": nrm(ks[9], (N_EVEN, D_MIX_EVEN, D_MODEL), D_MIX_EVEN),
        "odd_w_in": nrm(ks[10], (N_ODD, D_MODEL, D_IN_ODD), D_MODEL),
        "mla_kv_norm_g": gain(ks[11], (N_ODD, DSA_LATENT)),
        "mla_w_uk": nrm(ks[12], (N_ODD, DSA_HEADS, DSA_DH, DSA_LATENT), DSA_LATENT),
        "mla_w_uv": nrm(ks[13], (N_ODD, DSA_HEADS, DSA_LATENT, DSA_DH), DSA_LATENT),
        "odd_w_out": nrm(ks[14], (N_ODD, D_MIX_ODD, D_MODEL), D_MIX_ODD),
        "t5_table": 0.5 * jax.random.normal(ks[15], (T5_BUCKETS, DSA_HEADS), f32),
        "final_norm_g": gain(ks[16], (D_MODEL,)),
    }


def reference(x, norm_g, ffn_w_in, ffn_w_out, even_w_in, gla_w_gate, gla_b_gate, gla_norm_g, fox_b_f,
              even_w_out, odd_w_in, mla_kv_norm_g, mla_w_uk, mla_w_uv, odd_w_out, t5_table, final_norm_g):
    for layer in range(DEPTH):
        g = norm_g[layer]
        x = x + 0.5 * swiglu(rmsnorm(x, g[0]), ffn_w_in[layer, 0], ffn_w_out[layer, 0])
        h = rmsnorm(x, g[1])
        j = layer // 2
        if layer % 2 == 0:
            x = x + even_mixer(h, even_w_in[j], gla_w_gate[j], gla_b_gate[j], gla_norm_g[j], fox_b_f[j], even_w_out[j])
        else:
            x = x + odd_mixer(h, odd_w_in[j], mla_kv_norm_g[j], mla_w_uk[j], mla_w_uv[j], odd_w_out[j], t5_table)
        x = x + 0.5 * swiglu(rmsnorm(x, g[2]), ffn_w_in[layer, 1], ffn_w_out[layer, 1])
    return rmsnorm(x, final_norm_g)
```

```cpp
#include <hip/hip_runtime.h>
#include <cstdio>
#include <cstdint>
#include <cstring>
namespace pg8 {
#define PG8_LAS __attribute__((address_space(3)))
typedef unsigned short bf16_t;
typedef short bf16x8 __attribute__((ext_vector_type(8)));
typedef float f32x4 __attribute__((ext_vector_type(4)));
typedef unsigned u32x4 __attribute__((ext_vector_type(4)));
constexpr int BM = 256, BK = 64, HALF = 128, HTB = HALF * BK * 2  , STAGE_BYTES = 8 * HTB, NXCD = 8, WGM = 8;

__host__ __device__ __forceinline__ int lds_byte(int r, int c) { const int st = (r >> 4) * 2 + (c >> 5), rr = r & 15, cc = c & 31, ob = rr * 64 + cc * 2; return st * 1024 + (ob ^ (((ob >> 9) & 1) << 5)); }
__host__ __device__ __forceinline__ void stage_rc(int b, int& R, int& C) { const int st = b / 1024, sb = b % 1024, swz = sb ^ (((sb >> 9) & 1) << 5); R = (st >> 1) * 16 + swz / 64; C = (st & 1) * 32 + (swz % 64) / 2; }
__host__ __device__ __forceinline__ int perm32(int rho) { const int n = rho >> 4, i = rho & 15; return 8 * (i >> 2) + 4 * n + (i & 3); }

struct Unit { int pm, pn; };
struct Gemm { const bf16_t* A; const bf16_t* Bt; int M, N, K; };

struct StaticOrder {
    int nM, nN, nwg, G, c;
    __host__ __device__ void init(int M, int N, int G_, int c_) { nM = M / BM; nN = N / BM; nwg = nM * nN; G = G_; c = c_; }
    __host__ __device__ bool next(int i, Unit& u) const {
        const long L = (long)i * G + c; if (L >= nwg) return false;
        int wgid = (int)L; { const int q = nwg / NXCD, r = nwg % NXCD, xcd = wgid % NXCD, off = wgid / NXCD; wgid = (xcd < r ? xcd * (q + 1) : r * (q + 1) + (xcd - r) * q) + off; }
        const int nig = WGM * nN, gid = wgid / nig, fm = gid * WGM, gsz = (nM - fm) < WGM ? (nM - fm) : WGM;
        u.pm = fm + ((wgid % nig) % gsz); u.pn = (wgid % nig) / gsz; return true;
    }
    __device__ __forceinline__ void a_ready(const Unit&) const {}
    __device__ __forceinline__ void done(const Unit&) const {}
};

__device__ __forceinline__ unsigned cvt_pk_bf16(float lo, float hi) { unsigned r; asm volatile("v_cvt_pk_bf16_f32 %0, %1, %2" : "=v"(r) : "v"(lo), "v"(hi)); return r; }
__device__ __forceinline__ float silu_f(float a) { return a * __builtin_amdgcn_rcpf(1.0f + __builtin_amdgcn_exp2f(-1.4426950408889634f * a)); }

struct EpiSwiglu {
    static constexpr bool PERM = true, AFTER_DRAIN = false;
    bf16_t* O; int ldc;
    __device__ __forceinline__ void operator()(const f32x4 (&acc)[2][2][4][2], const Unit& u, int wr, int wc, int fr, int fq) const {
        const int row0 = u.pm * BM + wr * 64 + fr, col0 = u.pn * HALF + wc * 32 + 8 * fq;
#pragma unroll
        for (int ai = 0; ai < 2; ++ai)
#pragma unroll
            for (int m = 0; m < 4; ++m) { bf16_t* rowp = O + (size_t)(row0 + ai * HALF + m * 16) * ldc + col0;
                const f32x4 a0 = acc[ai][0][m][0], a1 = acc[ai][0][m][1], b0 = acc[ai][1][m][0], b1 = acc[ai][1][m][1];
                u32x4 w; w.x = cvt_pk_bf16(silu_f(a0[0]) * b0[0], silu_f(a0[1]) * b0[1]); w.y = cvt_pk_bf16(silu_f(a0[2]) * b0[2], silu_f(a0[3]) * b0[3]);
                w.z = cvt_pk_bf16(silu_f(a1[0]) * b1[0], silu_f(a1[1]) * b1[1]); w.w = cvt_pk_bf16(silu_f(a1[2]) * b1[2], silu_f(a1[3]) * b1[3]);
                *(u32x4*)rowp = w; }
    }
};
struct EpiResid {
    static constexpr bool PERM = false, AFTER_DRAIN = false;
    const float* base; float* out; int ldc; float scale;
    __device__ __forceinline__ void operator()(const f32x4 (&acc)[2][2][4][2], const Unit& u, int wr, int wc, int fr, int fq) const {
        const int row0 = u.pm * BM + wr * 64 + fr, col0 = u.pn * BM + wc * 32 + 4 * fq;
#pragma unroll
        for (int ai = 0; ai < 2; ++ai)
#pragma unroll
            for (int m = 0; m < 4; ++m) { const size_t ro = (size_t)(row0 + ai * HALF + m * 16) * ldc + col0;
#pragma unroll
                for (int bj = 0; bj < 2; ++bj)
#pragma unroll
                    for (int n = 0; n < 2; ++n) { const f32x4 b = *(const f32x4*)(base + ro + bj * HALF + n * 16); *(f32x4*)(out + ro + bj * HALF + n * 16) = b + acc[ai][bj][m][n] * scale; } }
    }
};
struct EpiProj {
    static constexpr bool PERM = true, AFTER_DRAIN = false;
    bf16_t* O; int ldc; int nbf; int tail_pn; int tail_wc; float* T; int ldt;
    __device__ __forceinline__ void operator()(const f32x4 (&acc)[2][2][4][2], const Unit& u, int wr, int wc, int fr, int fq) const {
        const int row0 = u.pm * BM + wr * 64 + fr, col0 = u.pn * BM + wc * 32 + 8 * fq;
        if (u.pn < nbf) {
#pragma unroll
            for (int ai = 0; ai < 2; ++ai)
#pragma unroll
                for (int m = 0; m < 4; ++m) { bf16_t* rowp = O + (size_t)(row0 + ai * HALF + m * 16) * ldc + col0;
#pragma unroll
                    for (int bj = 0; bj < 2; ++bj) { const f32x4 v0 = acc[ai][bj][m][0], v1 = acc[ai][bj][m][1];
                        u32x4 w; w.x = cvt_pk_bf16(v0[0], v0[1]); w.y = cvt_pk_bf16(v0[2], v0[3]); w.z = cvt_pk_bf16(v1[0], v1[1]); w.w = cvt_pk_bf16(v1[2], v1[3]);
                        *(u32x4*)(rowp + bj * HALF) = w; } }
        }
        if (u.pn == tail_pn && wc < tail_wc) {
#pragma unroll
            for (int ai = 0; ai < 2; ++ai)
#pragma unroll
                for (int m = 0; m < 4; ++m) { float* rowp = T + (size_t)(row0 + ai * HALF + m * 16) * ldt + wc * 32 + 8 * fq;
                    *(f32x4*)rowp = acc[ai][0][m][0]; *(f32x4*)(rowp + 4) = acc[ai][0][m][1]; }
        }
    }
};


template <class Epi, class Sched, bool ALIGN_EPI = false, bool SP2 = false>
__device__ __forceinline__ void gemm_phase(PG8_LAS unsigned char* lds, const Gemm g, const Sched& S, const Epi& E) {
    const int tid = threadIdx.x, wid = __builtin_amdgcn_readfirstlane(tid >> 6), lane = tid & 63, wr = wid >> 2, wc = wid & 3, fr = lane & 15, fq = lane >> 4;
    const int K = g.K, nt = K / BK;
    unsigned voffA[2], voffB[2];
#pragma unroll
    for (int i = 0; i < 2; ++i) { int R, C; stage_rc(tid * 16 + i * 8192, R, C); const int Rb = Epi::PERM ? ((R & ~31) + perm32(R & 31)) : R;
        voffA[i] = (unsigned)(R * K + C) * 2u; voffB[i] = (unsigned)(Rb * K + C) * 2u; }
    const size_t kstep = (size_t)(BK * 2);
    const size_t hstep = (size_t)HALF * K * 2;
    const size_t tstep = 2 * hstep;
    const unsigned ldsw = (unsigned)wid * 1024u;
    const int aoff = lds_byte(wr * 64 + fr, fq * 8), boff = lds_byte(wc * 32 + fr, fq * 8);
#define PG8_SA(b, h) (((b) * 2 + (h)) * HTB)
#define PG8_SB(b, h) ((4 + (b) * 2 + (h)) * HTB)
#define PG8_STAGE(bufoff, gbase, voff) do { _Pragma("unroll") for (int _i = 0; _i < 2; ++_i) \
        __builtin_amdgcn_global_load_lds((const unsigned*)((const char*)(gbase) + (voff)[_i]), (PG8_LAS unsigned*)(lds + (bufoff) + ldsw + _i * 8192), 16, 0, 0); } while (0)
#define PG8_LDA(dst, b, h) do { _Pragma("unroll") for (int m = 0; m < 4; ++m) _Pragma("unroll") for (int k = 0; k < 2; ++k) dst[m][k] = *(const PG8_LAS bf16x8*)(lds + PG8_SA(b, h) + aoff + m * 2048 + k * 1024); } while (0)
#define PG8_LDB(dst, b, h) do { _Pragma("unroll") for (int n = 0; n < 2; ++n) _Pragma("unroll") for (int k = 0; k < 2; ++k) dst[n][k] = *(const PG8_LAS bf16x8*)(lds + PG8_SB(b, h) + boff + n * 2048 + k * 1024); } while (0)
#define PG8_MMA(ai, bj, At, Bt) do { __builtin_amdgcn_s_setprio(1); _Pragma("unroll") for (int m = 0; m < 4; ++m) _Pragma("unroll") for (int n = 0; n < 2; ++n) _Pragma("unroll") for (int k = 0; k < 2; ++k) \
        acc[ai][bj][m][n] = __builtin_amdgcn_mfma_f32_16x16x32_bf16(Bt[n][k], At[m][k], acc[ai][bj][m][n], 0, 0, 0); __builtin_amdgcn_s_setprio(0); } while (0)
#define PG8_WAIT_V(n) asm volatile("s_waitcnt vmcnt(" #n ")" ::: "memory")
#define PG8_WAIT_L(n) asm volatile("s_waitcnt lgkmcnt(" #n ")" ::: "memory")
#define PG8_BAR __builtin_amdgcn_s_barrier()
#define PG8_SCHED __builtin_amdgcn_sched_barrier(0)
    Unit cur, nxt; int ui = 0;
    if (!S.next(0, cur)) return;
    f32x4 acc[2][2][4][2];
#pragma unroll
    for (int a = 0; a < 2; ++a)
#pragma unroll
        for (int b = 0; b < 2; ++b)
#pragma unroll
            for (int m = 0; m < 4; ++m)
#pragma unroll
                for (int n = 0; n < 2; ++n) acc[a][b][m][n] = (f32x4){0.f, 0.f, 0.f, 0.f};
    bf16x8 At[4][2], B0[2][2], B1[2][2];
    const char* cA = (const char*)g.A + (size_t)cur.pm * tstep; const char* cB = (const char*)g.Bt + (size_t)cur.pn * tstep;
    S.a_ready(cur);
    if constexpr (SP2) {
        PG8_STAGE(PG8_SB(0, 0), cB, voffB); PG8_STAGE(PG8_SB(0, 1), cB + hstep, voffB); PG8_STAGE(PG8_SA(0, 0), cA, voffA); PG8_STAGE(PG8_SA(0, 1), cA + hstep, voffA);
        if (wr == 1) PG8_BAR;
        PG8_WAIT_V(2); PG8_BAR;
        PG8_STAGE(PG8_SB(1, 0), cB + kstep, voffB); PG8_STAGE(PG8_SA(1, 0), cA + kstep, voffA); PG8_STAGE(PG8_SB(1, 1), cB + hstep + kstep, voffB);
        PG8_WAIT_V(6); PG8_BAR;
    } else {
        PG8_STAGE(PG8_SB(0, 0), cB, voffB); PG8_STAGE(PG8_SA(0, 0), cA, voffA); PG8_STAGE(PG8_SB(0, 1), cB + hstep, voffB); PG8_STAGE(PG8_SA(0, 1), cA + hstep, voffA);
        if (wr == 1) PG8_BAR;
        PG8_WAIT_V(4); PG8_BAR;
        PG8_STAGE(PG8_SB(1, 0), cB + kstep, voffB); PG8_STAGE(PG8_SA(1, 0), cA + kstep, voffA); PG8_STAGE(PG8_SB(1, 1), cB + hstep + kstep, voffB);
        PG8_WAIT_V(6); PG8_BAR;
    }
    for (;;) {
        const bool has_next = S.next(ui + 1, nxt);
        const char* nA = has_next ? (const char*)g.A + (size_t)nxt.pm * tstep : cA; const char* nB = has_next ? (const char*)g.Bt + (size_t)nxt.pn * tstep : cB;
        for (int t = 0; t < nt; t += 2) {
            const bool last = (t == nt - 2);
            const char* a1 = cA + (size_t)(t + 1) * kstep;
            const char* a2 = last ? nA : cA + (size_t)(t + 2) * kstep; const char* b2 = last ? nB : cB + (size_t)(t + 2) * kstep;
            const char* a3 = a2 + kstep; const char* b3 = b2 + kstep;
            if (last && has_next) S.a_ready(nxt);
            if constexpr (SP2) {
            PG8_LDB(B0, 0, 0); PG8_LDB(B1, 0, 1); PG8_SCHED; PG8_LDA(At, 0, 0); PG8_STAGE(PG8_SA(1, 1), a1 + hstep, voffA);
            PG8_WAIT_V(8); PG8_WAIT_L(0); PG8_BAR; PG8_MMA(0, 0, At, B0); PG8_MMA(0, 1, At, B1); PG8_BAR; PG8_SCHED;
            PG8_LDA(At, 0, 1); PG8_STAGE(PG8_SB(0, 0), b2, voffB); PG8_STAGE(PG8_SB(0, 1), b2 + hstep, voffB); PG8_STAGE(PG8_SA(0, 0), a2, voffA);
            PG8_WAIT_V(8); PG8_WAIT_L(0); PG8_BAR; PG8_MMA(1, 0, At, B0); PG8_MMA(1, 1, At, B1); PG8_BAR; PG8_SCHED;
            PG8_LDB(B0, 1, 0); PG8_LDB(B1, 1, 1); PG8_SCHED; PG8_LDA(At, 1, 0); PG8_STAGE(PG8_SA(0, 1), a2 + hstep, voffA);
            PG8_WAIT_V(8); PG8_WAIT_L(0); PG8_BAR; PG8_MMA(0, 0, At, B0); PG8_MMA(0, 1, At, B1); PG8_BAR; PG8_SCHED;
            PG8_LDA(At, 1, 1); PG8_STAGE(PG8_SB(1, 0), b3, voffB); PG8_STAGE(PG8_SB(1, 1), b3 + hstep, voffB); PG8_STAGE(PG8_SA(1, 0), a3, voffA);
            PG8_WAIT_V(8); PG8_WAIT_L(0); PG8_BAR; PG8_MMA(1, 0, At, B0); PG8_MMA(1, 1, At, B1); PG8_BAR; PG8_SCHED;
            } else {
            PG8_LDB(B0, 0, 0); PG8_SCHED; PG8_LDA(At, 0, 0); PG8_STAGE(PG8_SA(1, 1), a1 + hstep, voffA);
            PG8_WAIT_L(8); PG8_BAR; PG8_WAIT_L(0); PG8_MMA(0, 0, At, B0); PG8_BAR; PG8_SCHED;
            PG8_LDB(B1, 0, 1); PG8_STAGE(PG8_SB(0, 0), b2, voffB);
            PG8_BAR; PG8_WAIT_L(0); PG8_MMA(0, 1, At, B1); PG8_BAR;
            PG8_LDA(At, 0, 1); PG8_STAGE(PG8_SA(0, 0), a2, voffA);
            PG8_BAR; PG8_WAIT_L(0); PG8_MMA(1, 0, At, B0); PG8_BAR; PG8_SCHED;
            PG8_STAGE(PG8_SB(0, 1), b2 + hstep, voffB);
            PG8_WAIT_V(6); PG8_BAR; PG8_MMA(1, 1, At, B1); PG8_BAR;
            PG8_LDB(B0, 1, 0); PG8_SCHED; PG8_LDA(At, 1, 0); PG8_STAGE(PG8_SA(0, 1), a2 + hstep, voffA);
            PG8_WAIT_L(8); PG8_BAR; PG8_WAIT_L(0); PG8_MMA(0, 0, At, B0); PG8_BAR; PG8_SCHED;
            PG8_LDB(B1, 1, 1); PG8_STAGE(PG8_SB(1, 0), b3, voffB);
            PG8_BAR; PG8_WAIT_L(0); PG8_MMA(0, 1, At, B1); PG8_BAR;
            PG8_LDA(At, 1, 1); PG8_STAGE(PG8_SA(1, 0), a3, voffA);
            PG8_BAR; PG8_WAIT_L(0); PG8_MMA(1, 0, At, B0); PG8_BAR; PG8_SCHED;
            PG8_STAGE(PG8_SB(1, 1), b3 + hstep, voffB);
            PG8_WAIT_V(6); PG8_BAR; PG8_MMA(1, 1, At, B1); PG8_BAR;
            }
        }
        if constexpr (ALIGN_EPI) { if (wr == 0) PG8_BAR; }
        if constexpr (!Epi::AFTER_DRAIN) { E(acc, cur, wr, wc, fr, fq); S.done(cur); }
        if (!has_next) break;
#pragma unroll
        for (int a = 0; a < 2; ++a)
#pragma unroll
            for (int b = 0; b < 2; ++b)
#pragma unroll
                for (int m = 0; m < 4; ++m)
#pragma unroll
                    for (int n = 0; n < 2; ++n) acc[a][b][m][n] = (f32x4){0.f, 0.f, 0.f, 0.f};
        cur = nxt; cA = nA; cB = nB; ++ui;
        if constexpr (ALIGN_EPI) { if (wr == 1) PG8_BAR; }
    }
    PG8_WAIT_V(0);
    if constexpr (!ALIGN_EPI) { if (wr == 0) PG8_BAR; }
    PG8_BAR;
    if constexpr (Epi::AFTER_DRAIN) { E.fused(acc, cur, wr, wc, fr, fq, lds, wid, lane); S.done(cur); }
#undef PG8_SA
#undef PG8_SB
#undef PG8_STAGE
#undef PG8_LDA
#undef PG8_LDB
#undef PG8_MMA
#undef PG8_WAIT_V
#undef PG8_WAIT_L
#undef PG8_BAR
#undef PG8_SCHED
}
}
constexpr int BATCH = 8, SEQ = 4096, DM = 1024, M = BATCH * SEQ, DFF = 2816;
constexpr int NE_IN = 3328, NE_BF = 3072, NO_IN = 2048;
constexpr float EPS = 1e-6f;
typedef unsigned short bf16;
typedef unsigned v4u __attribute__((ext_vector_type(4)));
typedef float f32x4 __attribute__((ext_vector_type(4)));
#define LAS __attribute__((address_space(3)))
#define GAS __attribute__((address_space(1)))
constexpr size_t MiB = 1u << 20;
constexpr size_t WS_CTL = 0, WS_F = 1 * MiB;
constexpr size_t WS_WFI = 2 * MiB, WS_WFO = 46 * MiB, WS_WEI = 68 * MiB, WS_WEO = 75 * MiB, WS_WOI = 77 * MiB, WS_WOO = 81 * MiB;
constexpr size_t WS_HB = 84 * MiB;
constexpr size_t WS_BIG = 148 * MiB;
constexpr size_t WS_TE = WS_BIG + 192 * MiB, WS_TO = WS_BIG + 128 * MiB;
constexpr size_t WS_AUX = 344 * MiB;
constexpr size_t WS_GK = WS_AUX, WS_ALPHA = WS_AUX + 32 * MiB, WS_OG = WS_AUX + 64 * MiB;
constexpr size_t WS_C = WS_AUX, WS_IDX = WS_AUX + 16 * MiB;
constexpr size_t WS_END = 512 * MiB;
constexpr size_t FI_BYTES = (size_t)2 * DFF * DM * 2, FO_BYTES = (size_t)DM * DFF * 2;

__device__ __forceinline__ unsigned f2bf(float f) { unsigned u = __builtin_bit_cast(unsigned, f); return (u + 0x7fffu + ((u >> 16) & 1u)) >> 16; }
__device__ __forceinline__ unsigned pk2(float lo, float hi) { return f2bf(lo) | (f2bf(hi) << 16); }
__device__ __forceinline__ float bf2f(unsigned short b) { return __builtin_bit_cast(float, (unsigned)b << 16); }
__device__ __forceinline__ float wave_sum(float v) {
#pragma unroll
    for (int o = 1; o < 64; o <<= 1) v += __shfl_xor(v, o);
    return v;
}
__device__ __forceinline__ float wave_max(float v) {
#pragma unroll
    for (int o = 1; o < 64; o <<= 1) v = fmaxf(v, __shfl_xor(v, o));
    return v;
}
__device__ __forceinline__ float log_sigmoid(float x) { return fminf(x, 0.f) - log1pf(expf(-fabsf(x))); }

struct WDesc { const float* src; bf16* dst; int K, Ns, Nd, kind; };
__device__ __forceinline__ int src_col(int kind, int n, int Ns) {
    if (kind == 1) { const int j = n >> 8, r = n & 255; return r < 128 ? 128 * j + r : DFF + 128 * j + (r - 128); }
    if (kind == 2) { if (n < 1536) return n; if (n < 3072) return n + 16; if (n < 3088) return 1536 + (n - 3072); if (n < 3096) return n; return -1; }
    return n < Ns ? n : -1;
}
__device__ __forceinline__ void transpose_item(const WDesc& w, LAS float* scr, int item, int lane) {
    const int nblk = w.Nd / 32, kb = item / nblk, nb = item % nblk, k0 = 64 * kb, n0 = 32 * nb;
    const int sc = src_col(w.kind, n0 + (lane & 31), w.Ns);
#pragma unroll 8
    for (int i = 0; i < 32; ++i) { const int kk = 2 * i + (lane >> 5); scr[kk * 33 + (lane & 31)] = sc >= 0 ? w.src[(size_t)(k0 + kk) * w.Ns + sc] : 0.f; }
    asm volatile("s_waitcnt lgkmcnt(0)" ::: "memory");
    const int c = lane & 7;
#pragma unroll
    for (int j = 0; j < 4; ++j) { const int n = (lane >> 3) + 8 * j; const LAS float* s = scr + (8 * c) * 33 + n;
        v4u o; o.x = pk2(s[0 * 33], s[1 * 33]); o.y = pk2(s[2 * 33], s[3 * 33]); o.z = pk2(s[4 * 33], s[5 * 33]); o.w = pk2(s[6 * 33], s[7 * 33]);
        *(v4u*)(w.dst + (size_t)(n0 + n) * w.K + k0 + 8 * c) = o; }
    asm volatile("s_waitcnt lgkmcnt(0)" ::: "memory");
}
struct ProArgs { WDesc w[12]; };
__global__ void __launch_bounds__(256) k_prologue(ProArgs a) {
    __shared__ float scr_all[4 * 64 * 33];
    const int lane = threadIdx.x & 63, wave = threadIdx.x >> 6;
    LAS float* scr = (LAS float*)scr_all + wave * 64 * 33;
    const int gw = blockIdx.x * 4 + wave, NGW = gridDim.x * 4;
    for (int i = 0; i < 12; ++i) {
        const WDesc w = a.w[i];
        const int nitems = (w.Nd / 32) * (w.K / 64);
        for (int it = gw; it < nitems; it += NGW) transpose_item(w, scr, it, lane);
    }
}

template <bool F32OUT> __global__ void __launch_bounds__(512) k_norm(const float* X, const float* g, bf16* Ob, float* Of) {
    const int lane = threadIdx.x & 63, wave = threadIdx.x >> 6;
    const int gw = blockIdx.x * 8 + wave, NGW = gridDim.x * 8;
    f32x4 gv[4];
#pragma unroll
    for (int j = 0; j < 4; ++j) gv[j] = ((const f32x4*)g)[lane + 64 * j];
    for (int m = gw; m < M; m += NGW) {
        const f32x4* xr = (const f32x4*)(X + (size_t)m * DM) + lane;
        f32x4 v[4]; float s = 0.f;
#pragma unroll
        for (int j = 0; j < 4; ++j) { v[j] = xr[64 * j]; s += (v[j].x * v[j].x + v[j].y * v[j].y) + (v[j].z * v[j].z + v[j].w * v[j].w); }
        const float rstd = rsqrtf(wave_sum(s) * (1.f / DM) + EPS);
        if (F32OUT) {
            f32x4* o = (f32x4*)(Of + (size_t)m * DM) + lane;
#pragma unroll
            for (int j = 0; j < 4; ++j) o[64 * j] = v[j] * rstd * gv[j];
        } else {
            unsigned long long* o8 = (unsigned long long*)(Ob + (size_t)m * DM) + lane;
#pragma unroll
            for (int j = 0; j < 4; ++j) { const f32x4 y = v[j] * rstd * gv[j]; o8[64 * j] = (unsigned long long)pk2(y.x, y.y) | ((unsigned long long)pk2(y.z, y.w) << 32); }
        }
    }
}

struct GemmArgs { const bf16* A; const bf16* Bt; int Mr, N, K, pad0; void* p0; void* p1; const void* p2; int i0, i1, i2, i3; float f0; int pad1; };
template <class Epi> __device__ __forceinline__ Epi make_epi(const GemmArgs& a);
template <> __device__ __forceinline__ pg8::EpiSwiglu make_epi<pg8::EpiSwiglu>(const GemmArgs& a) { return pg8::EpiSwiglu{(bf16*)a.p0, a.i0}; }
template <> __device__ __forceinline__ pg8::EpiResid make_epi<pg8::EpiResid>(const GemmArgs& a) { return pg8::EpiResid{(const float*)a.p2, (float*)a.p0, a.i0, a.f0}; }
template <> __device__ __forceinline__ pg8::EpiProj make_epi<pg8::EpiProj>(const GemmArgs& a) { return pg8::EpiProj{(bf16*)a.p0, a.i0, a.i1, a.i2, a.i3, (float*)a.p1, (int)a.pad1}; }
template <class Epi> __global__ void __launch_bounds__(512, 2) k_gemm(GemmArgs a) {
    extern __shared__ __attribute__((aligned(16))) unsigned char lds[];
    pg8::Gemm g{a.A, a.Bt, a.Mr, a.N, a.K};
    pg8::StaticOrder S; S.init(a.Mr, a.N, (int)gridDim.x, (int)blockIdx.x);
    const Epi E = make_epi<Epi>(a);
    pg8::gemm_phase<Epi, pg8::StaticOrder, true, true>((PG8_LAS unsigned char*)lds, g, S, E);
}

__global__ void __launch_bounds__(256) k_gk(const float* TE, const float* Wg, const float* bg, float* GK, float* ALPHA) {
    const size_t i = (size_t)blockIdx.x * 256 + threadIdx.x; const int m = (int)(i >> 8), col = (int)(i & 255);
    float x = bg[col];
#pragma unroll
    for (int r = 0; r < 16; ++r) x += TE[(size_t)m * 32 + r] * Wg[r * 256 + col];
    const float gk = log_sigmoid(x) * (1.f / 16.f);
    GK[i] = gk; ALPHA[i] = expf(gk);
}
__global__ void __launch_bounds__(128) k_gla_rec(const bf16* PE, const float* ALPHA, float* OG) {
    const int b = blockIdx.x >> 2, h = blockIdx.x & 3, v = threadIdx.x;
    float S[64];
#pragma unroll
    for (int d = 0; d < 64; ++d) S[d] = 0.f;
    for (int t = 0; t < SEQ; ++t) {
        const size_t m = (size_t)b * SEQ + t;
        const bf16* pe = PE + m * NE_BF;
        const float vv = bf2f(pe[512 + h * 128 + v]);
        const float* al = ALPHA + m * 256 + h * 64;
        float o = 0.f;
#pragma unroll
        for (int d = 0; d < 64; ++d) {
            const float q = bf2f(pe[h * 64 + d]) * 0.125f, k = bf2f(pe[256 + h * 64 + d]);
            S[d] = al[d] * S[d] + k * vv; o += q * S[d];
        }
        OG[m * 512 + h * 128 + v] = o;
    }
}
__global__ void __launch_bounds__(256) k_gla_post(const float* OG, const bf16* PE, const float* gn, bf16* OMIX) {
    const int lane = threadIdx.x & 63; const size_t w = (size_t)blockIdx.x * 4 + (threadIdx.x >> 6); const size_t m = w >> 2; const int h = (int)(w & 3);
    const float o0 = OG[m * 512 + h * 128 + lane], o1 = OG[m * 512 + h * 128 + 64 + lane];
    const float rstd = rsqrtf(wave_sum(o0 * o0 + o1 * o1) * (1.f / 128.f) + EPS);
    const float g0 = bf2f(PE[m * NE_BF + 1024 + h * 128 + lane]), g1 = bf2f(PE[m * NE_BF + 1024 + h * 128 + 64 + lane]);
    OMIX[m * DM + h * 128 + lane] = (bf16)f2bf(o0 * rstd * gn[lane] * (g0 / (1.f + expf(-g0))));
    OMIX[m * DM + h * 128 + 64 + lane] = (bf16)f2bf(o1 * rstd * gn[64 + lane] * (g1 / (1.f + expf(-g1))));
}
__global__ void __launch_bounds__(64) k_fox_scan(const float* TE, const float* bfv, float* F) {
    const int b = blockIdx.x >> 3, h = blockIdx.x & 7, lane = threadIdx.x;
    const float bb = bfv[h];
    float s = 0.f;
    for (int i = 0; i < 64; ++i) s += log_sigmoid(TE[((size_t)b * SEQ + lane * 64 + i) * 32 + 16 + h] + bb);
    float inc = s;
#pragma unroll
    for (int o = 1; o < 64; o <<= 1) { const float y = __shfl_up(inc, o); if (lane >= o) inc += y; }
    float run = inc - s;
    for (int i = 0; i < 64; ++i) { run += log_sigmoid(TE[((size_t)b * SEQ + lane * 64 + i) * 32 + 16 + h] + bb); F[(size_t)blockIdx.x * SEQ + lane * 64 + i] = run; }
}
__global__ void __launch_bounds__(64) k_fox_naive(const bf16* PE, const float* F, bf16* OMIX) {
    const int bh = blockIdx.x >> 6, b = bh >> 3, h = bh & 7, t0 = (blockIdx.x & 63) * 64, t = t0 + threadIdx.x;
    const size_t m = (size_t)b * SEQ + t;
    float q[64], o[64];
#pragma unroll
    for (int d = 0; d < 64; ++d) { q[d] = bf2f(PE[m * NE_BF + 1536 + h * 64 + d]) * 0.125f; o[d] = 0.f; }
    const float* Fr = F + (size_t)bh * SEQ; const float Ft = Fr[t];
    float mr = -INFINITY, l = 0.f;
    for (int s = 0; s <= t0 + 63; ++s) {
        if (s <= t) {
            const bf16* kr = PE + ((size_t)b * SEQ + s) * NE_BF + 2048 + h * 64; const bf16* vr = kr + 512;
            float dot = 0.f;
#pragma unroll
            for (int d = 0; d < 64; ++d) dot += q[d] * bf2f(kr[d]);
            const float sc = dot + Ft - Fr[s];
            const float mn = fmaxf(mr, sc), corr = expf(mr - mn), p = expf(sc - mn);
            l = l * corr + p; mr = mn;
#pragma unroll
            for (int d = 0; d < 64; ++d) o[d] = o[d] * corr + p * bf2f(vr[d]);
        }
    }
    const float il = 1.f / l;
#pragma unroll
    for (int d = 0; d < 64; ++d) OMIX[m * DM + 512 + h * 64 + d] = (bf16)f2bf(o[d] * il);
}

__global__ void __launch_bounds__(256) k_ckv_norm(const bf16* PO, const float* g, bf16* C) {
    const int lane = threadIdx.x & 63; const size_t m = (size_t)blockIdx.x * 4 + (threadIdx.x >> 6);
    const bf16* r = PO + m * NO_IN + 1024 + lane * 4;
    const float x0 = bf2f(r[0]), x1 = bf2f(r[1]), x2 = bf2f(r[2]), x3 = bf2f(r[3]);
    const float rstd = rsqrtf(wave_sum(x0 * x0 + x1 * x1 + x2 * x2 + x3 * x3) * (1.f / 256.f) + EPS);
    bf16* o = C + m * 256 + lane * 4;
    o[0] = (bf16)f2bf(x0 * rstd * g[lane * 4]); o[1] = (bf16)f2bf(x1 * rstd * g[lane * 4 + 1]); o[2] = (bf16)f2bf(x2 * rstd * g[lane * 4 + 2]); o[3] = (bf16)f2bf(x3 * rstd * g[lane * 4 + 3]);
}
__device__ __forceinline__ unsigned ord_key(float x) { const unsigned u = __builtin_bit_cast(unsigned, x); return (u & 0x80000000u) ? ~u : (u | 0x80000000u); }
__global__ void __launch_bounds__(256) k_index_naive(const bf16* PO, const float* TO, int* IDX) {
    __shared__ float qi[512]; __shared__ float wsc[8]; __shared__ unsigned sk[SEQ]; __shared__ unsigned cnt; __shared__ unsigned cnt2;
    const size_t m = blockIdx.x; const int b = (int)(m >> 12), t = (int)(m & 4095), tid = threadIdx.x;
    for (int j = tid; j < 512; j += 256) qi[j] = bf2f(PO[m * NO_IN + 1280 + j]);
    if (tid < 8) wsc[tid] = TO[m * 96 + 64 + tid] * 0.35355339059327373f;
    __syncthreads();
    for (int s = tid; s <= t; s += 256) {
        const float* kr = TO + ((size_t)b * SEQ + s) * 96;
        float kk[64];
#pragma unroll
        for (int d = 0; d < 64; ++d) kk[d] = kr[d];
        float sc = 0.f;
#pragma unroll
        for (int hh = 0; hh < 8; ++hh) { float dot = 0.f;
#pragma unroll
            for (int d = 0; d < 64; ++d) dot += qi[hh * 64 + d] * kk[d];
            sc += wsc[hh] * fmaxf(dot * 0.125f, 0.f); }
        sk[s] = ord_key(sc);
    }
    __syncthreads();
    int* out = IDX + m * 256;
    if (t < 256) { out[tid] = tid <= t ? tid : -1; return; }
    unsigned tau = 0u;
    for (int bit = 31; bit >= 0; --bit) {
        const unsigned cand = tau | (1u << bit);
        if (tid == 0) cnt = 0u;
        __syncthreads();
        unsigned c = 0u;
        for (int s = tid; s <= t; s += 256) c += sk[s] >= cand ? 1u : 0u;
        if (c) atomicAdd(&cnt, c);
        __syncthreads();
        if (cnt >= 256u) tau = cand;
        __syncthreads();
    }
    if (tid == 0) { cnt = 0u; cnt2 = 0u; }
    __syncthreads();
    for (int s = tid; s <= t; s += 256) { if (sk[s] > tau) { const unsigned p = atomicAdd(&cnt, 1u); out[p] = s; } else if (sk[s] == tau) atomicAdd(&cnt2, 1u); }
    __syncthreads();
    const unsigned ngt = cnt, neq = cnt2, r = 256u - ngt;
    if (neq == r) { for (int s = tid; s <= t; s += 256) if (sk[s] == tau) { const unsigned p = atomicAdd(&cnt, 1u); out[p] = s; } }
    else if (tid == 0) { unsigned p = ngt; for (int s = 0; s <= t && p < 256u; ++s) if (sk[s] == tau) out[p++] = s; }
}
__device__ __forceinline__ int t5_bucket(int dist) {
    if (dist < 16) return dist;
    const int large = 16 + (int)(logf((float)dist * (1.f / 16.f)) / 2.0794415416798357f * 16.f);
    return large < 31 ? large : 31;
}
__global__ void __launch_bounds__(256) k_dsa_naive(const bf16* PO, const bf16* C, const int* IDX, const float* Wuk, const float* Wuv, const float* t5, bf16* OMIX) {
    __shared__ float qs[1024]; __shared__ __attribute__((aligned(16))) float ql[16 * 256]; __shared__ __attribute__((aligned(16))) float P[256 * 16]; __shared__ float ol[16 * 256]; __shared__ int ids[256];
    const size_t m = blockIdx.x; const int b = (int)(m >> 12), t = (int)(m & 4095), tid = threadIdx.x, lane = tid & 63, wave = tid >> 6;
    for (int j = tid; j < 1024; j += 256) qs[j] = bf2f(PO[m * NO_IN + j]);
    const int idx = IDX[m * 256 + tid]; ids[tid] = idx;
    __syncthreads();
    for (int hh = 0; hh < 16; ++hh) { float a = 0.f;
        for (int d = 0; d < 64; ++d) a += qs[hh * 64 + d] * Wuk[((size_t)hh * 64 + d) * 256 + tid];
        ql[hh * 256 + tid] = a; }
    __syncthreads();
    {
        float s[16];
#pragma unroll
        for (int hh = 0; hh < 16; ++hh) s[hh] = 0.f;
        const bool valid = idx >= 0 && idx <= t;
        if (valid) {
            const bf16* cr = C + ((size_t)b * SEQ + idx) * 256;
            for (int l0 = 0; l0 < 256; l0 += 8) {
                float cv[8];
#pragma unroll
                for (int j = 0; j < 8; ++j) cv[j] = bf2f(cr[l0 + j]);
#pragma unroll
                for (int hh = 0; hh < 16; ++hh)
#pragma unroll
                    for (int j = 0; j < 8; ++j) s[hh] += ql[hh * 256 + l0 + j] * cv[j];
            }
            const int bk = t5_bucket(t - idx);
#pragma unroll
            for (int hh = 0; hh < 16; ++hh) s[hh] = s[hh] * 0.125f + t5[bk * 16 + hh];
        } else {
#pragma unroll
            for (int hh = 0; hh < 16; ++hh) s[hh] = -INFINITY;
        }
#pragma unroll
        for (int hh = 0; hh < 16; ++hh) P[tid * 16 + hh] = s[hh];
    }
    __syncthreads();
    for (int hq = 0; hq < 4; ++hq) { const int hh = wave * 4 + hq;
        float v[4]; float mx = -INFINITY;
#pragma unroll
        for (int j = 0; j < 4; ++j) { v[j] = P[(lane + 64 * j) * 16 + hh]; mx = fmaxf(mx, v[j]); }
        mx = wave_max(mx); float sm = 0.f;
#pragma unroll
        for (int j = 0; j < 4; ++j) { v[j] = expf(v[j] - mx); sm += v[j]; }
        sm = wave_sum(sm); const float inv = 1.f / sm;
#pragma unroll
        for (int j = 0; j < 4; ++j) P[(lane + 64 * j) * 16 + hh] = v[j] * inv; }
    __syncthreads();
    {
        float o[16];
#pragma unroll
        for (int hh = 0; hh < 16; ++hh) o[hh] = 0.f;
        for (int k = 0; k < 256; ++k) { const int id = ids[k]; if (id < 0 || id > t) continue;
            const float cv = bf2f(C[((size_t)b * SEQ + id) * 256 + tid]);
#pragma unroll
            for (int hh = 0; hh < 16; ++hh) o[hh] += P[k * 16 + hh] * cv; }
#pragma unroll
        for (int hh = 0; hh < 16; ++hh) ol[hh * 256 + tid] = o[hh];
    }
    __syncthreads();
    { const int hh = tid >> 4, d0 = (tid & 15) * 4; f32x4 a = {0.f, 0.f, 0.f, 0.f};
        for (int l = 0; l < 256; ++l) { const f32x4 w = *(const f32x4*)(Wuv + ((size_t)hh * 256 + l) * 64 + d0); a += w * ol[hh * 256 + l]; }
        bf16* o = OMIX + m * DM + hh * 64 + d0; o[0] = (bf16)f2bf(a.x); o[1] = (bf16)f2bf(a.y); o[2] = (bf16)f2bf(a.z); o[3] = (bf16)f2bf(a.w); }
}

template <class Epi> static void launch_gemm(hipStream_t st, const bf16* A, const bf16* Bt, int N, int K, void* p0, void* p1, const void* p2, int i0, int i1, int i2, int i3, int ldt, float f0) {
    GemmArgs a; memset(&a, 0, sizeof(a));
    a.A = A; a.Bt = Bt; a.Mr = M; a.N = N; a.K = K; a.p0 = p0; a.p1 = p1; a.p2 = p2; a.i0 = i0; a.i1 = i1; a.i2 = i2; a.i3 = i3; a.f0 = f0; a.pad1 = ldt;
    hipLaunchKernelGGL(k_gemm<Epi>, dim3(256), dim3(512), 131072, st, a);
}
extern "C" void kernel_launch(void* const* d_in, const int* in_sizes, int n_in, void* d_out, int out_size, void* d_ws, size_t ws_size, hipStream_t stream) {
    static int inited = 0;
    if (!inited) {
        if (n_in != 17 || ws_size < WS_END) { fprintf(stderr, "kernel_launch: unexpected n_in %d or ws_size %zu\n", n_in, ws_size); inited = -1; return; }
        hipFuncSetAttribute((const void*)k_gemm<pg8::EpiSwiglu>, hipFuncAttributeMaxDynamicSharedMemorySize, 131072);
        hipFuncSetAttribute((const void*)k_gemm<pg8::EpiResid>, hipFuncAttributeMaxDynamicSharedMemorySize, 131072);
        hipFuncSetAttribute((const void*)k_gemm<pg8::EpiProj>, hipFuncAttributeMaxDynamicSharedMemorySize, 131072);
        inited = 1;
    }
    if (inited < 0) return;
    const float* x = (const float*)d_in[0]; const float* norm_g = (const float*)d_in[1]; const float* ffn_w_in = (const float*)d_in[2]; const float* ffn_w_out = (const float*)d_in[3];
    const float* even_w_in = (const float*)d_in[4]; const float* gla_w_gate = (const float*)d_in[5]; const float* gla_b_gate = (const float*)d_in[6]; const float* gla_norm_g = (const float*)d_in[7];
    const float* fox_b_f = (const float*)d_in[8]; const float* even_w_out = (const float*)d_in[9]; const float* odd_w_in = (const float*)d_in[10]; const float* kv_norm_g = (const float*)d_in[11];
    const float* w_uk = (const float*)d_in[12]; const float* w_uv = (const float*)d_in[13]; const float* odd_w_out = (const float*)d_in[14]; const float* t5 = (const float*)d_in[15]; const float* final_g = (const float*)d_in[16];
    unsigned char* ws = (unsigned char*)d_ws; float* X = (float*)d_out;
    bf16* HB = (bf16*)(ws + WS_HB); bf16* BIG = (bf16*)(ws + WS_BIG); float* TE = (float*)(ws + WS_TE); float* TO = (float*)(ws + WS_TO);
    float* F = (float*)(ws + WS_F); float* GK = (float*)(ws + WS_GK); float* ALPHA = (float*)(ws + WS_ALPHA); float* OG = (float*)(ws + WS_OG);
    bf16* C = (bf16*)(ws + WS_C); int* IDX = (int*)(ws + WS_IDX);
    bf16* WFI = (bf16*)(ws + WS_WFI); bf16* WFO = (bf16*)(ws + WS_WFO); bf16* WEI = (bf16*)(ws + WS_WEI); bf16* WEO = (bf16*)(ws + WS_WEO); bf16* WOI = (bf16*)(ws + WS_WOI); bf16* WOO = (bf16*)(ws + WS_WOO);
    ProArgs pa; memset(&pa, 0, sizeof(pa));
    for (int i = 0; i < 4; ++i) {
        pa.w[i] = WDesc{ffn_w_in + (size_t)i * DM * 2 * DFF, (bf16*)((unsigned char*)WFI + i * FI_BYTES), DM, 2 * DFF, 2 * DFF, 1};
        pa.w[4 + i] = WDesc{ffn_w_out + (size_t)i * DFF * DM, (bf16*)((unsigned char*)WFO + i * FO_BYTES), DFF, DM, DM, 0};
    }
    pa.w[8] = WDesc{even_w_in, WEI, DM, 3096, NE_IN, 2}; pa.w[9] = WDesc{even_w_out, WEO, DM, DM, DM, 0};
    pa.w[10] = WDesc{odd_w_in, WOI, DM, 1864, NO_IN, 3}; pa.w[11] = WDesc{odd_w_out, WOO, DM, DM, DM, 0};
    hipLaunchKernelGGL(k_prologue, dim3(1024), dim3(256), 0, stream, pa);
    auto norm = [&](const float* src, const float* g) { hipLaunchKernelGGL(k_norm<false>, dim3(256), dim3(512), 0, stream, src, g, HB, (float*)nullptr); };
    auto ffn = [&](int idx, const float* base) {
        launch_gemm<pg8::EpiSwiglu>(stream, HB, (bf16*)((unsigned char*)WFI + idx * FI_BYTES), 2 * DFF, DM, BIG, nullptr, nullptr, DFF, 0, 0, 0, 0, 0.f);
        launch_gemm<pg8::EpiResid>(stream, BIG, (bf16*)((unsigned char*)WFO + idx * FO_BYTES), DM, DFF, X, nullptr, base, DM, 0, 0, 0, 0, 0.5f);
    };
    norm(x, norm_g + 0 * DM); ffn(0, x);
    norm(X, norm_g + 1 * DM);
    launch_gemm<pg8::EpiProj>(stream, HB, WEI, NE_IN, DM, BIG, TE, nullptr, NE_BF, 12, 12, 1, 32, 0.f);
    hipLaunchKernelGGL(k_gk, dim3(M), dim3(256), 0, stream, TE, gla_w_gate, gla_b_gate, GK, ALPHA);
    hipLaunchKernelGGL(k_gla_rec, dim3(32), dim3(128), 0, stream, BIG, ALPHA, OG);
    hipLaunchKernelGGL(k_gla_post, dim3(M), dim3(256), 0, stream, OG, BIG, gla_norm_g, HB);
    hipLaunchKernelGGL(k_fox_scan, dim3(64), dim3(64), 0, stream, TE, fox_b_f, F);
    hipLaunchKernelGGL(k_fox_naive, dim3(64 * 64), dim3(64), 0, stream, BIG, F, HB);
    launch_gemm<pg8::EpiResid>(stream, HB, WEO, DM, DM, X, nullptr, X, DM, 0, 0, 0, 0, 1.0f);
    norm(X, norm_g + 2 * DM); ffn(1, X);
    norm(X, norm_g + 3 * DM); ffn(2, X);
    norm(X, norm_g + 4 * DM);
    launch_gemm<pg8::EpiProj>(stream, HB, WOI, NO_IN, DM, BIG, TO, nullptr, NO_IN, 8, 7, 3, 96, 0.f);
    hipLaunchKernelGGL(k_ckv_norm, dim3(M / 4), dim3(256), 0, stream, BIG, kv_norm_g, C);
    hipLaunchKernelGGL(k_index_naive, dim3(M), dim3(256), 0, stream, BIG, TO, IDX);
    hipLaunchKernelGGL(k_dsa_naive, dim3(M), dim3(256), 0, stream, BIG, C, IDX, w_uk, w_uv, t5, HB);
    launch_gemm<pg8::EpiResid>(stream, HB, WOO, DM, DM, X, nullptr, X, DM, 0, 0, 0, 0, 1.0f);
    norm(X, norm_g + 5 * DM); ffn(3, X);
    hipLaunchKernelGGL(k_norm<true>, dim3(256), dim3(512), 0, stream, X, final_g, (bf16*)nullptr, X);
}
```

```cpp
#include <hip/hip_runtime.h>
#include <cstdio>
#include <cstdint>
#include <cstring>
namespace pg8 {
#define PG8_LAS __attribute__((address_space(3)))
typedef unsigned short bf16_t;
typedef short bf16x8 __attribute__((ext_vector_type(8)));
typedef float f32x4 __attribute__((ext_vector_type(4)));
typedef unsigned u32x4 __attribute__((ext_vector_type(4)));
constexpr int BM = 256, BK = 64, HALF = 128, HTB = HALF * BK * 2  , STAGE_BYTES = 8 * HTB, NXCD = 8, WGM = 8;

__host__ __device__ __forceinline__ int lds_byte(int r, int c) { const int st = (r >> 4) * 2 + (c >> 5), rr = r & 15, cc = c & 31, ob = rr * 64 + cc * 2; return st * 1024 + (ob ^ (((ob >> 9) & 1) << 5)); }
__host__ __device__ __forceinline__ void stage_rc(int b, int& R, int& C) { const int st = b / 1024, sb = b % 1024, swz = sb ^ (((sb >> 9) & 1) << 5); R = (st >> 1) * 16 + swz / 64; C = (st & 1) * 32 + (swz % 64) / 2; }
__host__ __device__ __forceinline__ int perm32(int rho) { const int n = rho >> 4, i = rho & 15; return 8 * (i >> 2) + 4 * n + (i & 3); }

struct Unit { int pm, pn; };
struct Gemm { const bf16_t* A; const bf16_t* Bt; int M, N, K; };

struct StaticOrder {
    int nM, nN, nwg, G, c;
    __host__ __device__ void init(int M, int N, int G_, int c_) { nM = M / BM; nN = N / BM; nwg = nM * nN; G = G_; c = c_; }
    __host__ __device__ bool next(int i, Unit& u) const {
        const long L = (long)i * G + c; if (L >= nwg) return false;
        int wgid = (int)L; { const int q = nwg / NXCD, r = nwg % NXCD, xcd = wgid % NXCD, off = wgid / NXCD; wgid = (xcd < r ? xcd * (q + 1) : r * (q + 1) + (xcd - r) * q) + off; }
        const int nig = WGM * nN, gid = wgid / nig, fm = gid * WGM, gsz = (nM - fm) < WGM ? (nM - fm) : WGM;
        u.pm = fm + ((wgid % nig) % gsz); u.pn = (wgid % nig) / gsz; return true;
    }
    __device__ __forceinline__ void a_ready(const Unit&) const {}
    __device__ __forceinline__ void done(const Unit&) const {}
};

typedef float f32x2_t __attribute__((ext_vector_type(2))); typedef __bf16 bf16x2_t __attribute__((ext_vector_type(2)));
__device__ __forceinline__ unsigned cvt_pk_bf16(float lo, float hi) { f32x2_t v = {lo, hi}; bf16x2_t b = __builtin_convertvector(v, bf16x2_t); return __builtin_bit_cast(unsigned, b); }
__device__ __forceinline__ float silu_f(float a) { return a * __builtin_amdgcn_rcpf(1.0f + __builtin_amdgcn_exp2f(-1.4426950408889634f * a)); }

struct EpiSwiglu {
    static constexpr bool PERM = true, AFTER_DRAIN = false;
    bf16_t* O; int ldc;
    __device__ __forceinline__ void operator()(const f32x4 (&acc)[2][2][4][2], const Unit& u, int wr, int wc, int fr, int fq) const {
        const int row0 = u.pm * BM + wr * 64 + fr, col0 = u.pn * HALF + wc * 32 + 8 * fq;
#pragma unroll
        for (int ai = 0; ai < 2; ++ai)
#pragma unroll
            for (int m = 0; m < 4; ++m) { bf16_t* rowp = O + (size_t)(row0 + ai * HALF + m * 16) * ldc + col0;
                const f32x4 a0 = acc[ai][0][m][0], a1 = acc[ai][0][m][1], b0 = acc[ai][1][m][0], b1 = acc[ai][1][m][1];
                u32x4 w; w.x = cvt_pk_bf16(silu_f(a0[0]) * b0[0], silu_f(a0[1]) * b0[1]); w.y = cvt_pk_bf16(silu_f(a0[2]) * b0[2], silu_f(a0[3]) * b0[3]);
                w.z = cvt_pk_bf16(silu_f(a1[0]) * b1[0], silu_f(a1[1]) * b1[1]); w.w = cvt_pk_bf16(silu_f(a1[2]) * b1[2], silu_f(a1[3]) * b1[3]);
                *(u32x4*)rowp = w; }
    }
};
struct EpiResid {
    static constexpr bool PERM = false, AFTER_DRAIN = false;
    const float* base; float* out; int ldc; float scale;
    __device__ __forceinline__ void operator()(const f32x4 (&acc)[2][2][4][2], const Unit& u, int wr, int wc, int fr, int fq) const {
        const int row0 = u.pm * BM + wr * 64 + fr, col0 = u.pn * BM + wc * 32 + 4 * fq;
#pragma unroll
        for (int ai = 0; ai < 2; ++ai)
#pragma unroll
            for (int m = 0; m < 4; ++m) { const size_t ro = (size_t)(row0 + ai * HALF + m * 16) * ldc + col0;
#pragma unroll
                for (int bj = 0; bj < 2; ++bj)
#pragma unroll
                    for (int n = 0; n < 2; ++n) { const f32x4 b = *(const f32x4*)(base + ro + bj * HALF + n * 16); *(f32x4*)(out + ro + bj * HALF + n * 16) = b + acc[ai][bj][m][n] * scale; } }
    }
};
struct EpiProj {
    static constexpr bool PERM = true, AFTER_DRAIN = false;
    bf16_t* O; int ldc; int nbf; int tail_pn; int tail_wc; float* T; int ldt;
    __device__ __forceinline__ void operator()(const f32x4 (&acc)[2][2][4][2], const Unit& u, int wr, int wc, int fr, int fq) const {
        const int row0 = u.pm * BM + wr * 64 + fr, col0 = u.pn * BM + wc * 32 + 8 * fq;
        if (u.pn < nbf) {
#pragma unroll
            for (int ai = 0; ai < 2; ++ai)
#pragma unroll
                for (int m = 0; m < 4; ++m) { bf16_t* rowp = O + (size_t)(row0 + ai * HALF + m * 16) * ldc + col0;
#pragma unroll
                    for (int bj = 0; bj < 2; ++bj) { const f32x4 v0 = acc[ai][bj][m][0], v1 = acc[ai][bj][m][1];
                        u32x4 w; w.x = cvt_pk_bf16(v0[0], v0[1]); w.y = cvt_pk_bf16(v0[2], v0[3]); w.z = cvt_pk_bf16(v1[0], v1[1]); w.w = cvt_pk_bf16(v1[2], v1[3]);
                        *(u32x4*)(rowp + bj * HALF) = w; } }
        }
        if (u.pn == tail_pn && wc < tail_wc) {
#pragma unroll
            for (int ai = 0; ai < 2; ++ai)
#pragma unroll
                for (int m = 0; m < 4; ++m) { float* rowp = T + (size_t)(row0 + ai * HALF + m * 16) * ldt + wc * 32 + 8 * fq;
                    *(f32x4*)rowp = acc[ai][0][m][0]; *(f32x4*)(rowp + 4) = acc[ai][0][m][1]; }
        }
    }
};


template <class Epi, class Sched, bool ALIGN_EPI = false, bool SP2 = false>
__device__ __forceinline__ void gemm_phase(PG8_LAS unsigned char* lds, const Gemm g, const Sched& S, const Epi& E) {
    const int tid = threadIdx.x, wid = __builtin_amdgcn_readfirstlane(tid >> 6), lane = tid & 63, wr = wid >> 2, wc = wid & 3, fr = lane & 15, fq = lane >> 4;
    const int K = g.K, nt = K / BK;
    unsigned voffA[2], voffB[2];
#pragma unroll
    for (int i = 0; i < 2; ++i) { int R, C; stage_rc(tid * 16 + i * 8192, R, C); const int Rb = Epi::PERM ? ((R & ~31) + perm32(R & 31)) : R;
        voffA[i] = (unsigned)(R * K + C) * 2u; voffB[i] = (unsigned)(Rb * K + C) * 2u; }
    const size_t kstep = (size_t)(BK * 2);
    const size_t hstep = (size_t)HALF * K * 2;
    const size_t tstep = 2 * hstep;
    const unsigned ldsw = (unsigned)wid * 1024u;
    const int aoff = lds_byte(wr * 64 + fr, fq * 8), boff = lds_byte(wc * 32 + fr, fq * 8);
#define PG8_SA(b, h) (((b) * 2 + (h)) * HTB)
#define PG8_SB(b, h) ((4 + (b) * 2 + (h)) * HTB)
#define PG8_STAGE(bufoff, gbase, voff) do { _Pragma("unroll") for (int _i = 0; _i < 2; ++_i) \
        __builtin_amdgcn_global_load_lds((const unsigned*)((const char*)(gbase) + (voff)[_i]), (PG8_LAS unsigned*)(lds + (bufoff) + ldsw + _i * 8192), 16, 0, 0); } while (0)
#define PG8_LDA(dst, b, h) do { _Pragma("unroll") for (int m = 0; m < 4; ++m) _Pragma("unroll") for (int k = 0; k < 2; ++k) dst[m][k] = *(const PG8_LAS bf16x8*)(lds + PG8_SA(b, h) + aoff + m * 2048 + k * 1024); } while (0)
#define PG8_LDB(dst, b, h) do { _Pragma("unroll") for (int n = 0; n < 2; ++n) _Pragma("unroll") for (int k = 0; k < 2; ++k) dst[n][k] = *(const PG8_LAS bf16x8*)(lds + PG8_SB(b, h) + boff + n * 2048 + k * 1024); } while (0)
#define PG8_MMA(ai, bj, At, Bt) do { __builtin_amdgcn_s_setprio(1); _Pragma("unroll") for (int m = 0; m < 4; ++m) _Pragma("unroll") for (int n = 0; n < 2; ++n) _Pragma("unroll") for (int k = 0; k < 2; ++k) \
        acc[ai][bj][m][n] = __builtin_amdgcn_mfma_f32_16x16x32_bf16(Bt[n][k], At[m][k], acc[ai][bj][m][n], 0, 0, 0); __builtin_amdgcn_s_setprio(0); } while (0)
#define PG8_WAIT_V(n) asm volatile("s_waitcnt vmcnt(" #n ")" ::: "memory")
#define PG8_WAIT_L(n) asm volatile("s_waitcnt lgkmcnt(" #n ")" ::: "memory")
#define PG8_BAR __builtin_amdgcn_s_barrier()
#define PG8_SCHED __builtin_amdgcn_sched_barrier(0)
    Unit cur, nxt; int ui = 0;
    if (!S.next(0, cur)) return;
    f32x4 acc[2][2][4][2];
#pragma unroll
    for (int a = 0; a < 2; ++a)
#pragma unroll
        for (int b = 0; b < 2; ++b)
#pragma unroll
            for (int m = 0; m < 4; ++m)
#pragma unroll
                for (int n = 0; n < 2; ++n) acc[a][b][m][n] = (f32x4){0.f, 0.f, 0.f, 0.f};
    bf16x8 At[4][2], B0[2][2], B1[2][2];
    const char* cA = (const char*)g.A + (size_t)cur.pm * tstep; const char* cB = (const char*)g.Bt + (size_t)cur.pn * tstep;
    S.a_ready(cur);
    if constexpr (SP2) {
        PG8_STAGE(PG8_SB(0, 0), cB, voffB); PG8_STAGE(PG8_SB(0, 1), cB + hstep, voffB); PG8_STAGE(PG8_SA(0, 0), cA, voffA); PG8_STAGE(PG8_SA(0, 1), cA + hstep, voffA);
        if (wr == 1) PG8_BAR;
        PG8_WAIT_V(2); PG8_BAR;
        PG8_STAGE(PG8_SB(1, 0), cB + kstep, voffB); PG8_STAGE(PG8_SA(1, 0), cA + kstep, voffA); PG8_STAGE(PG8_SB(1, 1), cB + hstep + kstep, voffB);
        PG8_WAIT_V(6); PG8_BAR;
    } else {
        PG8_STAGE(PG8_SB(0, 0), cB, voffB); PG8_STAGE(PG8_SA(0, 0), cA, voffA); PG8_STAGE(PG8_SB(0, 1), cB + hstep, voffB); PG8_STAGE(PG8_SA(0, 1), cA + hstep, voffA);
        if (wr == 1) PG8_BAR;
        PG8_WAIT_V(4); PG8_BAR;
        PG8_STAGE(PG8_SB(1, 0), cB + kstep, voffB); PG8_STAGE(PG8_SA(1, 0), cA + kstep, voffA); PG8_STAGE(PG8_SB(1, 1), cB + hstep + kstep, voffB);
        PG8_WAIT_V(6); PG8_BAR;
    }
    for (;;) {
        const bool has_next = S.next(ui + 1, nxt);
        const char* nA = has_next ? (const char*)g.A + (size_t)nxt.pm * tstep : cA; const char* nB = has_next ? (const char*)g.Bt + (size_t)nxt.pn * tstep : cB;
        for (int t = 0; t < nt; t += 2) {
            const bool last = (t == nt - 2);
            const char* a1 = cA + (size_t)(t + 1) * kstep;
            const char* a2 = last ? nA : cA + (size_t)(t + 2) * kstep; const char* b2 = last ? nB : cB + (size_t)(t + 2) * kstep;
            const char* a3 = a2 + kstep; const char* b3 = b2 + kstep;
            if (last && has_next) S.a_ready(nxt);
            if constexpr (SP2) {
            PG8_LDB(B0, 0, 0); PG8_LDB(B1, 0, 1); PG8_SCHED; PG8_LDA(At, 0, 0); PG8_STAGE(PG8_SA(1, 1), a1 + hstep, voffA);
            PG8_WAIT_V(8); PG8_WAIT_L(0); PG8_BAR; PG8_MMA(0, 0, At, B0); PG8_MMA(0, 1, At, B1); PG8_BAR; PG8_SCHED;
            PG8_LDA(At, 0, 1); PG8_STAGE(PG8_SB(0, 0), b2, voffB); PG8_STAGE(PG8_SB(0, 1), b2 + hstep, voffB); PG8_STAGE(PG8_SA(0, 0), a2, voffA);
            PG8_WAIT_V(8); PG8_WAIT_L(0); PG8_BAR; PG8_MMA(1, 0, At, B0); PG8_MMA(1, 1, At, B1); PG8_BAR; PG8_SCHED;
            PG8_LDB(B0, 1, 0); PG8_LDB(B1, 1, 1); PG8_SCHED; PG8_LDA(At, 1, 0); PG8_STAGE(PG8_SA(0, 1), a2 + hstep, voffA);
            PG8_WAIT_V(8); PG8_WAIT_L(0); PG8_BAR; PG8_MMA(0, 0, At, B0); PG8_MMA(0, 1, At, B1); PG8_BAR; PG8_SCHED;
            PG8_LDA(At, 1, 1); PG8_STAGE(PG8_SB(1, 0), b3, voffB); PG8_STAGE(PG8_SB(1, 1), b3 + hstep, voffB); PG8_STAGE(PG8_SA(1, 0), a3, voffA);
            PG8_WAIT_V(8); PG8_WAIT_L(0); PG8_BAR; PG8_MMA(1, 0, At, B0); PG8_MMA(1, 1, At, B1); PG8_BAR; PG8_SCHED;
            } else {
            PG8_LDB(B0, 0, 0); PG8_SCHED; PG8_LDA(At, 0, 0); PG8_STAGE(PG8_SA(1, 1), a1 + hstep, voffA);
            PG8_WAIT_L(8); PG8_BAR; PG8_WAIT_L(0); PG8_MMA(0, 0, At, B0); PG8_BAR; PG8_SCHED;
            PG8_LDB(B1, 0, 1); PG8_STAGE(PG8_SB(0, 0), b2, voffB);
            PG8_BAR; PG8_WAIT_L(0); PG8_MMA(0, 1, At, B1); PG8_BAR;
            PG8_LDA(At, 0, 1); PG8_STAGE(PG8_SA(0, 0), a2, voffA);
            PG8_BAR; PG8_WAIT_L(0); PG8_MMA(1, 0, At, B0); PG8_BAR; PG8_SCHED;
            PG8_STAGE(PG8_SB(0, 1), b2 + hstep, voffB);
            PG8_WAIT_V(6); PG8_BAR; PG8_MMA(1, 1, At, B1); PG8_BAR;
            PG8_LDB(B0, 1, 0); PG8_SCHED; PG8_LDA(At, 1, 0); PG8_STAGE(PG8_SA(0, 1), a2 + hstep, voffA);
            PG8_WAIT_L(8); PG8_BAR; PG8_WAIT_L(0); PG8_MMA(0, 0, At, B0); PG8_BAR; PG8_SCHED;
            PG8_LDB(B1, 1, 1); PG8_STAGE(PG8_SB(1, 0), b3, voffB);
            PG8_BAR; PG8_WAIT_L(0); PG8_MMA(0, 1, At, B1); PG8_BAR;
            PG8_LDA(At, 1, 1); PG8_STAGE(PG8_SA(1, 0), a3, voffA);
            PG8_BAR; PG8_WAIT_L(0); PG8_MMA(1, 0, At, B0); PG8_BAR; PG8_SCHED;
            PG8_STAGE(PG8_SB(1, 1), b3 + hstep, voffB);
            PG8_WAIT_V(6); PG8_BAR; PG8_MMA(1, 1, At, B1); PG8_BAR;
            }
        }
        if constexpr (ALIGN_EPI) { if (wr == 0) PG8_BAR; }
        if constexpr (!Epi::AFTER_DRAIN) { E(acc, cur, wr, wc, fr, fq); S.done(cur); }
        if (!has_next) break;
#pragma unroll
        for (int a = 0; a < 2; ++a)
#pragma unroll
            for (int b = 0; b < 2; ++b)
#pragma unroll
                for (int m = 0; m < 4; ++m)
#pragma unroll
                    for (int n = 0; n < 2; ++n) acc[a][b][m][n] = (f32x4){0.f, 0.f, 0.f, 0.f};
        cur = nxt; cA = nA; cB = nB; ++ui;
        if constexpr (ALIGN_EPI) { if (wr == 1) PG8_BAR; }
    }
    PG8_WAIT_V(0);
    if constexpr (!ALIGN_EPI) { if (wr == 0) PG8_BAR; }
    PG8_BAR;
    if constexpr (Epi::AFTER_DRAIN) { E.fused(acc, cur, wr, wc, fr, fq, lds, wid, lane); S.done(cur); }
#undef PG8_SA
#undef PG8_SB
#undef PG8_STAGE
#undef PG8_LDA
#undef PG8_LDB
#undef PG8_MMA
#undef PG8_WAIT_V
#undef PG8_WAIT_L
#undef PG8_BAR
#undef PG8_SCHED
}
}
constexpr int BATCH = 8, SEQ = 4096, DM = 1024, M = BATCH * SEQ, DFF = 2816;
constexpr int NE_IN = 3328, NE_BF = 3072, NO_IN = 2048;
constexpr float EPS = 1e-6f;
typedef unsigned short bf16;
typedef unsigned v4u __attribute__((ext_vector_type(4)));
typedef float f32x4 __attribute__((ext_vector_type(4)));
#define LAS __attribute__((address_space(3)))
#define GAS __attribute__((address_space(1)))
constexpr size_t MiB = 1u << 20;
constexpr size_t WS_CTL = 0, WS_F = 1 * MiB;
constexpr size_t WS_WFI = 2 * MiB, WS_WFO = 46 * MiB, WS_WEI = 68 * MiB, WS_WEO = 75 * MiB, WS_WOI = 77 * MiB, WS_WOO = 81 * MiB;
constexpr size_t WS_HB = 84 * MiB;
constexpr size_t WS_BIG = 148 * MiB;
constexpr size_t WS_TE = WS_BIG + 192 * MiB, WS_TO = WS_BIG + 128 * MiB;
constexpr size_t WS_AUX = 344 * MiB;
constexpr size_t WS_GK = WS_AUX, WS_ALPHA = WS_AUX + 32 * MiB, WS_OG = WS_AUX + 64 * MiB;
constexpr size_t WS_C = WS_AUX, WS_IDX = WS_AUX + 16 * MiB;
constexpr size_t WS_END = 512 * MiB;
constexpr size_t FI_BYTES = (size_t)2 * DFF * DM * 2, FO_BYTES = (size_t)DM * DFF * 2;

__device__ __forceinline__ unsigned f2bf(float f) { unsigned u = __builtin_bit_cast(unsigned, f); return (u + 0x7fffu + ((u >> 16) & 1u)) >> 16; }
__device__ __forceinline__ unsigned pk2(float lo, float hi) { return f2bf(lo) | (f2bf(hi) << 16); }
__device__ __forceinline__ float bf2f(unsigned short b) { return __builtin_bit_cast(float, (unsigned)b << 16); }
__device__ __forceinline__ float wave_sum(float v) {
#pragma unroll
    for (int o = 1; o < 64; o <<= 1) v += __shfl_xor(v, o);
    return v;
}
__device__ __forceinline__ float wave_max(float v) {
#pragma unroll
    for (int o = 1; o < 64; o <<= 1) v = fmaxf(v, __shfl_xor(v, o));
    return v;
}
__device__ __forceinline__ float log_sigmoid(float x) { return fminf(x, 0.f) - log1pf(expf(-fabsf(x))); }

struct WDesc { const float* src; bf16* dst; int K, Ns, Nd, kind; };
__device__ __forceinline__ int src_col(int kind, int n, int Ns) {
    if (kind == 1) { const int j = n >> 8, r = n & 255; return r < 128 ? 128 * j + r : DFF + 128 * j + (r - 128); }
    if (kind == 2) { if (n < 1536) return n; if (n < 3072) return n + 16; if (n < 3088) return 1536 + (n - 3072); if (n < 3096) return n; return -1; }
    return n < Ns ? n : -1;
}
__device__ __forceinline__ void transpose_item(const WDesc& w, LAS float* scr, int item, int lane) {
    const int nblk = w.Nd / 32, kb = item / nblk, nb = item % nblk, k0 = 64 * kb, n0 = 32 * nb;
    const int sc = src_col(w.kind, n0 + (lane & 31), w.Ns);
#pragma unroll 8
    for (int i = 0; i < 32; ++i) { const int kk = 2 * i + (lane >> 5); scr[kk * 33 + (lane & 31)] = sc >= 0 ? w.src[(size_t)(k0 + kk) * w.Ns + sc] : 0.f; }
    asm volatile("s_waitcnt lgkmcnt(0)" ::: "memory");
    const int c = lane & 7;
#pragma unroll
    for (int j = 0; j < 4; ++j) { const int n = (lane >> 3) + 8 * j; const LAS float* s = scr + (8 * c) * 33 + n;
        v4u o; o.x = pk2(s[0 * 33], s[1 * 33]); o.y = pk2(s[2 * 33], s[3 * 33]); o.z = pk2(s[4 * 33], s[5 * 33]); o.w = pk2(s[6 * 33], s[7 * 33]);
        *(v4u*)(w.dst + (size_t)(n0 + n) * w.K + k0 + 8 * c) = o; }
    asm volatile("s_waitcnt lgkmcnt(0)" ::: "memory");
}
struct ProArgs { WDesc w[44]; };
__global__ void __launch_bounds__(256) k_prologue(ProArgs a) {
    __shared__ float scr_all[4 * 64 * 33];
    const int lane = threadIdx.x & 63, wave = threadIdx.x >> 6;
    LAS float* scr = (LAS float*)scr_all + wave * 64 * 33;
    const int gw = blockIdx.x * 4 + wave, NGW = gridDim.x * 4;
    for (int i = 0; i < 44; ++i) {
        const WDesc w = a.w[i];
        const int nitems = (w.Nd / 32) * (w.K / 64);
        for (int it = gw; it < nitems; it += NGW) transpose_item(w, scr, it, lane);
    }
}

template <bool F32OUT> __global__ void __launch_bounds__(512) k_norm(const float* X, const float* g, bf16* Ob, float* Of) {
    const int lane = threadIdx.x & 63, wave = threadIdx.x >> 6;
    const int gw = blockIdx.x * 8 + wave, NGW = gridDim.x * 8;
    f32x4 gv[4];
#pragma unroll
    for (int j = 0; j < 4; ++j) gv[j] = ((const f32x4*)g)[lane + 64 * j];
    for (int m = gw; m < M; m += NGW) {
        const f32x4* xr = (const f32x4*)(X + (size_t)m * DM) + lane;
        f32x4 v[4]; float s = 0.f;
#pragma unroll
        for (int j = 0; j < 4; ++j) { v[j] = xr[64 * j]; s += (v[j].x * v[j].x + v[j].y * v[j].y) + (v[j].z * v[j].z + v[j].w * v[j].w); }
        const float rstd = rsqrtf(wave_sum(s) * (1.f / DM) + EPS);
        if (F32OUT) {
            f32x4* o = (f32x4*)(Of + (size_t)m * DM) + lane;
#pragma unroll
            for (int j = 0; j < 4; ++j) o[64 * j] = v[j] * rstd * gv[j];
        } else {
            unsigned long long* o8 = (unsigned long long*)(Ob + (size_t)m * DM) + lane;
#pragma unroll
            for (int j = 0; j < 4; ++j) { const f32x4 y = v[j] * rstd * gv[j]; o8[64 * j] = (unsigned long long)pk2(y.x, y.y) | ((unsigned long long)pk2(y.z, y.w) << 32); }
        }
    }
}

struct GemmArgs { const bf16* A; const bf16* Bt; int Mr, N, K, pad0; void* p0; void* p1; const void* p2; int i0, i1, i2, i3; float f0; int pad1; };
template <class Epi> __device__ __forceinline__ Epi make_epi(const GemmArgs& a);
template <> __device__ __forceinline__ pg8::EpiSwiglu make_epi<pg8::EpiSwiglu>(const GemmArgs& a) { return pg8::EpiSwiglu{(bf16*)a.p0, a.i0}; }
template <> __device__ __forceinline__ pg8::EpiResid make_epi<pg8::EpiResid>(const GemmArgs& a) { return pg8::EpiResid{(const float*)a.p2, (float*)a.p0, a.i0, a.f0}; }
template <> __device__ __forceinline__ pg8::EpiProj make_epi<pg8::EpiProj>(const GemmArgs& a) { return pg8::EpiProj{(bf16*)a.p0, a.i0, a.i1, a.i2, a.i3, (float*)a.p1, (int)a.pad1}; }
template <class Epi> __global__ void __launch_bounds__(512, 2) k_gemm(GemmArgs a) {
    extern __shared__ __attribute__((aligned(16))) unsigned char lds[];
    pg8::Gemm g{a.A, a.Bt, a.Mr, a.N, a.K};
    pg8::StaticOrder S; S.init(a.Mr, a.N, (int)gridDim.x, (int)blockIdx.x);
    const Epi E = make_epi<Epi>(a);
    pg8::gemm_phase<Epi, pg8::StaticOrder, true, true>((PG8_LAS unsigned char*)lds, g, S, E);
}

__global__ void __launch_bounds__(256) k_gk(const float* TE, const float* Wg, const float* bg, float* GK, float* ALPHA) {
    const size_t i = (size_t)blockIdx.x * 256 + threadIdx.x; const int m = (int)(i >> 8), col = (int)(i & 255);
    float x = bg[col];
#pragma unroll
    for (int r = 0; r < 16; ++r) x += TE[(size_t)m * 32 + r] * Wg[r * 256 + col];
    const float gk = log_sigmoid(x) * (1.f / 16.f);
    GK[i] = gk; ALPHA[i] = expf(gk);
}
__global__ void __launch_bounds__(128) k_gla_rec(const bf16* PE, const float* ALPHA, float* OG) {
    const int b = blockIdx.x >> 2, h = blockIdx.x & 3, v = threadIdx.x;
    float S[64];
#pragma unroll
    for (int d = 0; d < 64; ++d) S[d] = 0.f;
    for (int t = 0; t < SEQ; ++t) {
        const size_t m = (size_t)b * SEQ + t;
        const bf16* pe = PE + m * NE_BF;
        const float vv = bf2f(pe[512 + h * 128 + v]);
        const float* al = ALPHA + m * 256 + h * 64;
        float o = 0.f;
#pragma unroll
        for (int d = 0; d < 64; ++d) {
            const float q = bf2f(pe[h * 64 + d]) * 0.125f, k = bf2f(pe[256 + h * 64 + d]);
            S[d] = al[d] * S[d] + k * vv; o += q * S[d];
        }
        OG[m * 512 + h * 128 + v] = o;
    }
}
__global__ void __launch_bounds__(256) k_gla_post(const float* OG, const bf16* PE, const float* gn, bf16* OMIX) {
    const int lane = threadIdx.x & 63; const size_t w = (size_t)blockIdx.x * 4 + (threadIdx.x >> 6); const size_t m = w >> 2; const int h = (int)(w & 3);
    const float o0 = OG[m * 512 + h * 128 + lane], o1 = OG[m * 512 + h * 128 + 64 + lane];
    const float rstd = rsqrtf(wave_sum(o0 * o0 + o1 * o1) * (1.f / 128.f) + EPS);
    const float g0 = bf2f(PE[m * NE_BF + 1024 + h * 128 + lane]), g1 = bf2f(PE[m * NE_BF + 1024 + h * 128 + 64 + lane]);
    OMIX[m * DM + h * 128 + lane] = (bf16)f2bf(o0 * rstd * gn[lane] * (g0 / (1.f + expf(-g0))));
    OMIX[m * DM + h * 128 + 64 + lane] = (bf16)f2bf(o1 * rstd * gn[64 + lane] * (g1 / (1.f + expf(-g1))));
}
__global__ void __launch_bounds__(64) k_fox_scan(const float* TE, const float* bfv, float* F) {
    const int b = blockIdx.x >> 3, h = blockIdx.x & 7, lane = threadIdx.x;
    const float bb = bfv[h];
    float s = 0.f;
    for (int i = 0; i < 64; ++i) s += log_sigmoid(TE[((size_t)b * SEQ + lane * 64 + i) * 32 + 16 + h] + bb);
    float inc = s;
#pragma unroll
    for (int o = 1; o < 64; o <<= 1) { const float y = __shfl_up(inc, o); if (lane >= o) inc += y; }
    float run = inc - s;
    for (int i = 0; i < 64; ++i) { run += log_sigmoid(TE[((size_t)b * SEQ + lane * 64 + i) * 32 + 16 + h] + bb); F[(size_t)blockIdx.x * SEQ + lane * 64 + i] = run; }
}
__global__ void __launch_bounds__(64) k_fox_naive(const bf16* PE, const float* F, bf16* OMIX) {
    const int bh = blockIdx.x >> 6, b = bh >> 3, h = bh & 7, t0 = (blockIdx.x & 63) * 64, t = t0 + threadIdx.x;
    const size_t m = (size_t)b * SEQ + t;
    float q[64], o[64];
#pragma unroll
    for (int d = 0; d < 64; ++d) { q[d] = bf2f(PE[m * NE_BF + 1536 + h * 64 + d]) * 0.125f; o[d] = 0.f; }
    const float* Fr = F + (size_t)bh * SEQ; const float Ft = Fr[t];
    float mr = -INFINITY, l = 0.f;
    for (int s = 0; s <= t0 + 63; ++s) {
        if (s <= t) {
            const bf16* kr = PE + ((size_t)b * SEQ + s) * NE_BF + 2048 + h * 64; const bf16* vr = kr + 512;
            float dot = 0.f;
#pragma unroll
            for (int d = 0; d < 64; ++d) dot += q[d] * bf2f(kr[d]);
            const float sc = dot + Ft - Fr[s];
            const float mn = fmaxf(mr, sc), corr = expf(mr - mn), p = expf(sc - mn);
            l = l * corr + p; mr = mn;
#pragma unroll
            for (int d = 0; d < 64; ++d) o[d] = o[d] * corr + p * bf2f(vr[d]);
        }
    }
    const float il = 1.f / l;
#pragma unroll
    for (int d = 0; d < 64; ++d) OMIX[m * DM + 512 + h * 64 + d] = (bf16)f2bf(o[d] * il);
}

__global__ void __launch_bounds__(256) k_ckv_norm(const bf16* PO, const float* g, bf16* C) {
    const int lane = threadIdx.x & 63; const size_t m = (size_t)blockIdx.x * 4 + (threadIdx.x >> 6);
    const bf16* r = PO + m * NO_IN + 1024 + lane * 4;
    const float x0 = bf2f(r[0]), x1 = bf2f(r[1]), x2 = bf2f(r[2]), x3 = bf2f(r[3]);
    const float rstd = rsqrtf(wave_sum(x0 * x0 + x1 * x1 + x2 * x2 + x3 * x3) * (1.f / 256.f) + EPS);
    bf16* o = C + m * 256 + lane * 4;
    o[0] = (bf16)f2bf(x0 * rstd * g[lane * 4]); o[1] = (bf16)f2bf(x1 * rstd * g[lane * 4 + 1]); o[2] = (bf16)f2bf(x2 * rstd * g[lane * 4 + 2]); o[3] = (bf16)f2bf(x3 * rstd * g[lane * 4 + 3]);
}
__device__ __forceinline__ unsigned ord_key(float x) { const unsigned u = __builtin_bit_cast(unsigned, x); return (u & 0x80000000u) ? ~u : (u | 0x80000000u); }
__global__ void __launch_bounds__(256) k_index_naive(const bf16* PO, const float* TO, int* IDX) {
    __shared__ float qi[512]; __shared__ float wsc[8]; __shared__ unsigned sk[SEQ]; __shared__ unsigned cnt; __shared__ unsigned cnt2;
    const size_t m = blockIdx.x; const int b = (int)(m >> 12), t = (int)(m & 4095), tid = threadIdx.x;
    for (int j = tid; j < 512; j += 256) qi[j] = bf2f(PO[m * NO_IN + 1280 + j]);
    if (tid < 8) wsc[tid] = TO[m * 96 + 64 + tid] * 0.35355339059327373f;
    __syncthreads();
    for (int s = tid; s <= t; s += 256) {
        const float* kr = TO + ((size_t)b * SEQ + s) * 96;
        float kk[64];
#pragma unroll
        for (int d = 0; d < 64; ++d) kk[d] = kr[d];
        float sc = 0.f;
#pragma unroll
        for (int hh = 0; hh < 8; ++hh) { float dot = 0.f;
#pragma unroll
            for (int d = 0; d < 64; ++d) dot += qi[hh * 64 + d] * kk[d];
            sc += wsc[hh] * fmaxf(dot * 0.125f, 0.f); }
        sk[s] = ord_key(sc);
    }
    __syncthreads();
    int* out = IDX + m * 256;
    if (t < 256) { out[tid] = tid <= t ? tid : -1; return; }
    unsigned tau = 0u;
    for (int bit = 31; bit >= 0; --bit) {
        const unsigned cand = tau | (1u << bit);
        if (tid == 0) cnt = 0u;
        __syncthreads();
        unsigned c = 0u;
        for (int s = tid; s <= t; s += 256) c += sk[s] >= cand ? 1u : 0u;
        if (c) atomicAdd(&cnt, c);
        __syncthreads();
        if (cnt >= 256u) tau = cand;
        __syncthreads();
    }
    if (tid == 0) { cnt = 0u; cnt2 = 0u; }
    __syncthreads();
    for (int s = tid; s <= t; s += 256) { if (sk[s] > tau) { const unsigned p = atomicAdd(&cnt, 1u); out[p] = s; } else if (sk[s] == tau) atomicAdd(&cnt2, 1u); }
    __syncthreads();
    const unsigned ngt = cnt, neq = cnt2, r = 256u - ngt;
    if (neq == r) { for (int s = tid; s <= t; s += 256) if (sk[s] == tau) { const unsigned p = atomicAdd(&cnt, 1u); out[p] = s; } }
    else if (tid == 0) { unsigned p = ngt; for (int s = 0; s <= t && p < 256u; ++s) if (sk[s] == tau) out[p++] = s; }
}
__device__ __forceinline__ int t5_bucket(int dist) {
    if (dist < 16) return dist;
    const int large = 16 + (int)(logf((float)dist * (1.f / 16.f)) / 2.0794415416798357f * 16.f);
    return large < 31 ? large : 31;
}
__global__ void __launch_bounds__(256) k_dsa_naive(const bf16* PO, const bf16* C, const int* IDX, const float* Wuk, const float* Wuv, const float* t5, bf16* OMIX) {
    __shared__ float qs[1024]; __shared__ __attribute__((aligned(16))) float ql[16 * 256]; __shared__ __attribute__((aligned(16))) float P[256 * 16]; __shared__ float ol[16 * 256]; __shared__ int ids[256];
    const size_t m = blockIdx.x; const int b = (int)(m >> 12), t = (int)(m & 4095), tid = threadIdx.x, lane = tid & 63, wave = tid >> 6;
    for (int j = tid; j < 1024; j += 256) qs[j] = bf2f(PO[m * NO_IN + j]);
    const int idx = IDX[m * 256 + tid]; ids[tid] = idx;
    __syncthreads();
    for (int hh = 0; hh < 16; ++hh) { float a = 0.f;
        for (int d = 0; d < 64; ++d) a += qs[hh * 64 + d] * Wuk[((size_t)hh * 64 + d) * 256 + tid];
        ql[hh * 256 + tid] = a; }
    __syncthreads();
    {
        float s[16];
#pragma unroll
        for (int hh = 0; hh < 16; ++hh) s[hh] = 0.f;
        const bool valid = idx >= 0 && idx <= t;
        if (valid) {
            const bf16* cr = C + ((size_t)b * SEQ + idx) * 256;
            for (int l0 = 0; l0 < 256; l0 += 8) {
                float cv[8];
#pragma unroll
                for (int j = 0; j < 8; ++j) cv[j] = bf2f(cr[l0 + j]);
#pragma unroll
                for (int hh = 0; hh < 16; ++hh)
#pragma unroll
                    for (int j = 0; j < 8; ++j) s[hh] += ql[hh * 256 + l0 + j] * cv[j];
            }
            const int bk = t5_bucket(t - idx);
#pragma unroll
            for (int hh = 0; hh < 16; ++hh) s[hh] = s[hh] * 0.125f + t5[bk * 16 + hh];
        } else {
#pragma unroll
            for (int hh = 0; hh < 16; ++hh) s[hh] = -INFINITY;
        }
#pragma unroll
        for (int hh = 0; hh < 16; ++hh) P[tid * 16 + hh] = s[hh];
    }
    __syncthreads();
    for (int hq = 0; hq < 4; ++hq) { const int hh = wave * 4 + hq;
        float v[4]; float mx = -INFINITY;
#pragma unroll
        for (int j = 0; j < 4; ++j) { v[j] = P[(lane + 64 * j) * 16 + hh]; mx = fmaxf(mx, v[j]); }
        mx = wave_max(mx); float sm = 0.f;
#pragma unroll
        for (int j = 0; j < 4; ++j) { v[j] = expf(v[j] - mx); sm += v[j]; }
        sm = wave_sum(sm); const float inv = 1.f / sm;
#pragma unroll
        for (int j = 0; j < 4; ++j) P[(lane + 64 * j) * 16 + hh] = v[j] * inv; }
    __syncthreads();
    {
        float o[16];
#pragma unroll
        for (int hh = 0; hh < 16; ++hh) o[hh] = 0.f;
        for (int k = 0; k < 256; ++k) { const int id = ids[k]; if (id < 0 || id > t) continue;
            const float cv = bf2f(C[((size_t)b * SEQ + id) * 256 + tid]);
#pragma unroll
            for (int hh = 0; hh < 16; ++hh) o[hh] += P[k * 16 + hh] * cv; }
#pragma unroll
        for (int hh = 0; hh < 16; ++hh) ol[hh * 256 + tid] = o[hh];
    }
    __syncthreads();
    { const int hh = tid >> 4, d0 = (tid & 15) * 4; f32x4 a = {0.f, 0.f, 0.f, 0.f};
        for (int l = 0; l < 256; ++l) { const f32x4 w = *(const f32x4*)(Wuv + ((size_t)hh * 256 + l) * 64 + d0); a += w * ol[hh * 256 + l]; }
        bf16* o = OMIX + m * DM + hh * 64 + d0; o[0] = (bf16)f2bf(a.x); o[1] = (bf16)f2bf(a.y); o[2] = (bf16)f2bf(a.z); o[3] = (bf16)f2bf(a.w); }
}

namespace fox {
typedef short bf16x8 __attribute__((ext_vector_type(8)));
typedef short s16x4 __attribute__((ext_vector_type(4)));
typedef float f32x16 __attribute__((ext_vector_type(16)));
constexpr int PITCH = NE_BF;
constexpr float C2 = 0.125f * 1.4426950408889634f, L2E = 1.4426950408889634f;
constexpr int L_K = 0, L_V = 16384, L_NB = 32768, L_AL = 49152, L_MM = 50176, LDS_BYTES = 50432;
__device__ __forceinline__ int crow(int r, int hi) { return (r & 3) + 8 * (r >> 2) + 4 * hi; }
__device__ __forceinline__ unsigned cvtpk(float lo, float hi) { return pg8::cvt_pk_bf16(lo, hi); }

__device__ __forceinline__ void attn_unit(int b, int h, int qb, const bf16* PE, const float* F, bf16* OMIX, LAS unsigned char* lds) {
    const int tid = threadIdx.x, lane = tid & 63, r32 = lane & 31, hi = lane >> 5; const int wid = __builtin_amdgcn_readfirstlane(tid >> 6);
    const size_t rowbase = (size_t)b * SEQ; const int q0 = qb * 256;
    const bf16* Qw = PE + (rowbase + q0 + wid * 32) * PITCH + 1536 + h * 64;
    const bf16* Kh = PE + rowbase * PITCH + 2048 + h * 64; const bf16* Vh = Kh + 512;
    const float* Fr = F + (size_t)(b * 8 + h) * SEQ;
    LAS float* nb = (LAS float*)(lds + L_NB);
    LAS float* al = (LAS float*)(lds + L_AL) + wid * 32;
    const float Fq0 = Fr[q0];
    for (int s = tid; s < q0 + 256; s += 512) nb[s] = (Fq0 - Fr[s]) * L2E;
    bf16x8 qr[4];
#pragma unroll
    for (int d0 = 0; d0 < 4; ++d0) qr[d0] = *(const bf16x8*)(Qw + (size_t)r32 * PITCH + d0 * 16 + hi * 8);
    const int NT = (q0 + 256) / 64;
    const int qrow = q0 + wid * 32 + r32;
    const int wtop = (q0 + wid * 32 + 31) >> 6;
    const bf16* ksrc = Kh + (size_t)lane * PITCH + wid * 8;
    const bf16* vsrc = Vh + (size_t)(16 * (wid & 3) + (lane >> 2)) * PITCH + (wid >> 2) * 32 + (lane & 3) * 8;
    const int stg = wid * 1024 + lane * 16;
    v4u kreg = *(const v4u*)(ksrc + (size_t)(NT - 1) * 64 * PITCH), vreg = *(const v4u*)(vsrc + (size_t)(NT - 1) * 64 * PITCH);
    float mrun = -INFINITY, lrun = 0.f; f32x16 o0, o1;
#pragma unroll
    for (int r = 0; r < 16; ++r) { o0[r] = 0.f; o1[r] = 0.f; }
    const int vbl = ((lane >> 4) & 1) * 32 + (lane & 3) * 8 + (4 * hi + ((lane & 15) >> 2)) * 64;
    int it = 0;
    for (int t = NT - 1; t >= 0; --t, ++it) {
        const int slot = (it & 1) * 8192;
        *(LAS v4u*)(lds + L_K + slot + stg) = kreg; *(LAS v4u*)(lds + L_V + slot + stg) = vreg;
        __syncthreads();
        if (t > 0) { kreg = *(const v4u*)(ksrc + (size_t)(t - 1) * 64 * PITCH); vreg = *(const v4u*)(vsrc + (size_t)(t - 1) * 64 * PITCH); }
        if (t <= wtop) {
            f32x16 p0, p1;
#pragma unroll
            for (int r = 0; r < 16; ++r) { p0[r] = 0.f; p1[r] = 0.f; }
            const LAS unsigned char* kb = lds + L_K + slot + hi * 1024 + r32 * 16;
#pragma unroll
            for (int d0 = 0; d0 < 4; ++d0) {
                const bf16x8 b0 = *(const LAS bf16x8*)(kb + d0 * 2048), b1 = *(const LAS bf16x8*)(kb + d0 * 2048 + 512);
                p0 = __builtin_amdgcn_mfma_f32_32x32x16_bf16(b0, qr[d0], p0, 0, 0, 0);
                p1 = __builtin_amdgcn_mfma_f32_32x32x16_bf16(b1, qr[d0], p1, 0, 0, 0);
            }
            const LAS float* nbt = nb + t * 64 + 4 * hi;
#pragma unroll
            for (int g = 0; g < 4; ++g) { const f32x4 n0 = *(const LAS f32x4*)(nbt + 8 * g), n1 = *(const LAS f32x4*)(nbt + 32 + 8 * g);
#pragma unroll
                for (int e = 0; e < 4; ++e) { p0[4 * g + e] = p0[4 * g + e] * C2 + n0[e]; p1[4 * g + e] = p1[4 * g + e] * C2 + n1[e]; } }
            if (t * 64 + 63 > q0 + wid * 32) {
#pragma unroll
                for (int r = 0; r < 16; ++r) { const int kv = t * 64 + crow(r, hi); if (kv > qrow) p0[r] = -INFINITY; if (kv + 32 > qrow) p1[r] = -INFINITY; }
            }
            float rm = -INFINITY;
#pragma unroll
            for (int r = 0; r < 16; ++r) rm = fmaxf(rm, fmaxf(p0[r], p1[r]));
            rm = fmaxf(rm, __shfl_xor(rm, 32));
            const float mnew = fmaxf(mrun, rm);
            const float alpha = __builtin_amdgcn_exp2f(mrun - mnew);
            mrun = mnew;
            float sum = 0.f;
#pragma unroll
            for (int r = 0; r < 16; ++r) { p0[r] = __builtin_amdgcn_exp2f(p0[r] - mnew); p1[r] = __builtin_amdgcn_exp2f(p1[r] - mnew); sum += p0[r] + p1[r]; }
            lrun = lrun * alpha + sum;
            if (hi == 0) al[r32] = alpha;
            asm volatile("s_waitcnt lgkmcnt(0)" ::: "memory");
#pragma unroll
            for (int g = 0; g < 4; ++g) { const f32x4 a4 = *(const LAS f32x4*)(al + 8 * g + 4 * hi);
#pragma unroll
                for (int e = 0; e < 4; ++e) { o0[4 * g + e] *= a4[e]; o1[4 * g + e] *= a4[e]; } }
            bf16x8 pa[4];
#pragma unroll
            for (int k = 0; k < 2; ++k) {
                v4u w0, w1;
                w0.x = cvtpk(p0[8 * k + 0], p0[8 * k + 1]); w0.y = cvtpk(p0[8 * k + 2], p0[8 * k + 3]); w0.z = cvtpk(p0[8 * k + 4], p0[8 * k + 5]); w0.w = cvtpk(p0[8 * k + 6], p0[8 * k + 7]);
                w1.x = cvtpk(p1[8 * k + 0], p1[8 * k + 1]); w1.y = cvtpk(p1[8 * k + 2], p1[8 * k + 3]); w1.z = cvtpk(p1[8 * k + 4], p1[8 * k + 5]); w1.w = cvtpk(p1[8 * k + 6], p1[8 * k + 7]);
                pa[k] = __builtin_bit_cast(bf16x8, w0); pa[2 + k] = __builtin_bit_cast(bf16x8, w1);
            }
            const unsigned vb = (unsigned)(size_t)(lds + L_V + slot) + vbl;
#pragma unroll
            for (int d0 = 0; d0 < 2; ++d0) {
                s16x4 lo[4], hh[4];
#pragma unroll
                for (int ks = 0; ks < 4; ++ks) {
                    asm volatile("ds_read_b64_tr_b16 %0, %1 offset:%c2" : "=&v"(lo[ks]) : "v"(vb), "i"(d0 * 4096 + ks * 1024) : "memory");
                    asm volatile("ds_read_b64_tr_b16 %0, %1 offset:%c2" : "=&v"(hh[ks]) : "v"(vb), "i"(d0 * 4096 + ks * 1024 + 512) : "memory");
                }
                asm volatile("s_waitcnt lgkmcnt(0)" ::: "memory"); __builtin_amdgcn_sched_barrier(0);
#pragma unroll
                for (int ks = 0; ks < 4; ++ks) {
                    const bf16x8 vf = (bf16x8){lo[ks][0], lo[ks][1], lo[ks][2], lo[ks][3], hh[ks][0], hh[ks][1], hh[ks][2], hh[ks][3]};
                    if (d0 == 0) o0 = __builtin_amdgcn_mfma_f32_32x32x16_bf16(pa[ks], vf, o0, 0, 0, 0); else o1 = __builtin_amdgcn_mfma_f32_32x32x16_bf16(pa[ks], vf, o1, 0, 0, 0);
                }
            }
        }
    }
    lrun += __shfl_xor(lrun, 32);
    if (hi == 0) al[r32] = 1.f / lrun;
    asm volatile("s_waitcnt lgkmcnt(0)" ::: "memory");
    bf16* Ow = OMIX + (rowbase + q0 + wid * 32) * DM + 512 + h * 64;
#pragma unroll
    for (int r = 0; r < 16; ++r) { const int orow = crow(r, hi); const float il = al[orow];
        Ow[(size_t)orow * DM + r32] = (bf16)f2bf(o0[r] * il); Ow[(size_t)orow * DM + 32 + r32] = (bf16)f2bf(o1[r] * il); }
    __syncthreads();
}
__device__ __forceinline__ void phase(LAS unsigned char* lds, const bf16* PE, const float* F, bf16* OMIX) {
    const int bx = blockIdx.x, G = gridDim.x; const int vcu = (G % 8 == 0) ? (bx % 8) * (G / 8) + bx / 8 : bx;
    for (int v = vcu; v < 256; v += G) {
        const int bh = v >> 2, sub = v & 3;
#pragma unroll 1
        for (int i = 0; i < 4; ++i) { const int qb = (i == 0) ? sub : (i == 1) ? 7 - sub : (i == 2) ? 8 + sub : 15 - sub; attn_unit(bh >> 3, bh & 7, qb, PE, F, OMIX, lds); }
    }
}
__device__ __forceinline__ void scan_phase(const float* TE, const float* bfv, float* F) {
    const int lane = threadIdx.x & 63, gw = blockIdx.x * 8 + (threadIdx.x >> 6), NGW = gridDim.x * 8;
    for (int bh = gw; bh < 64; bh += NGW) {
        const int b = bh >> 3, h = bh & 7; const float bb = bfv[h];
        float s = 0.f;
        for (int i = 0; i < 64; ++i) s += log_sigmoid(TE[((size_t)b * SEQ + lane * 64 + i) * 32 + 16 + h] + bb);
        float inc = s;
#pragma unroll
        for (int o = 1; o < 64; o <<= 1) { const float y = __shfl_up(inc, o); if (lane >= o) inc += y; }
        float run = inc - s;
        for (int i = 0; i < 64; ++i) { run += log_sigmoid(TE[((size_t)b * SEQ + lane * 64 + i) * 32 + 16 + h] + bb); F[(size_t)bh * SEQ + lane * 64 + i] = run; }
    }
}
}
__global__ void __launch_bounds__(512, 2) k_fox(const bf16* PE, const float* F, bf16* OMIX) {
    extern __shared__ __attribute__((aligned(16))) unsigned char lds[];
    fox::phase((LAS unsigned char*)lds, PE, F, OMIX);
}

namespace gla {
typedef short bf16x8 __attribute__((ext_vector_type(8)));
typedef short s16x4 __attribute__((ext_vector_type(4)));
typedef float f32x16 __attribute__((ext_vector_type(16)));
typedef float f32x2 __attribute__((ext_vector_type(2)));
constexpr int L_GS = 0, L_SEG = 16384, L_KD = 18432, L_QD = 26624, L_V = 34816, L_S = 51200, L_SSQ = 67584, LDS_BYTES = 68608;
__device__ __forceinline__ int crow(int r, int hi) { return (r & 3) + 8 * (r >> 2) + 4 * hi; }
__device__ __forceinline__ s16x4 trr(unsigned addr) { s16x4 r; asm volatile("ds_read_b64_tr_b16 %0, %1\n\ts_waitcnt lgkmcnt(0)" : "=&v"(r) : "v"(addr) : "memory"); return r; }
__device__ __forceinline__ bf16x8 cat(s16x4 a, s16x4 b) { return (bf16x8){a[0], a[1], a[2], a[3], b[0], b[1], b[2], b[3]}; }
__device__ __forceinline__ unsigned cvtpk(float lo, float hi) { return pg8::cvt_pk_bf16(lo, hi); }
__device__ __forceinline__ int tr_off(int row, int col) { return ((col >> 5) * 4 + (row >> 4)) * 1024 + (row & 15) * 64 + ((col >> 3) & 3) * 16; }

__device__ __forceinline__ void gates(LAS unsigned char* lds, const float* TE, const float* Wg, const float* bg, size_t m0, int h) {
    const int tid = threadIdx.x;
    LAS float* GS = (LAS float*)(lds + L_GS); LAS float* SEG = (LAS float*)(lds + L_SEG);
    { const int t = tid >> 3, dg = tid & 7; const float* te = TE + (m0 + t) * 32;
        float x[8];
#pragma unroll
        for (int e = 0; e < 8; ++e) x[e] = bg[h * 64 + dg * 8 + e];
#pragma unroll
        for (int r = 0; r < 16; ++r) { const float tv = te[r]; const f32x4 w0 = *(const f32x4*)(Wg + r * 256 + h * 64 + dg * 8), w1 = *(const f32x4*)(Wg + r * 256 + h * 64 + dg * 8 + 4);
            x[0] += tv * w0.x; x[1] += tv * w0.y; x[2] += tv * w0.z; x[3] += tv * w0.w; x[4] += tv * w1.x; x[5] += tv * w1.y; x[6] += tv * w1.z; x[7] += tv * w1.w; }
#pragma unroll
        for (int e = 0; e < 8; ++e) GS[t * 64 + dg * 8 + e] = log_sigmoid(x[e]) * (1.f / 16.f); }
    __syncthreads();
    { const int d = tid & 63, seg = tid >> 6; float run = 0.f;
#pragma unroll
        for (int i = 0; i < 8; ++i) { run += GS[(seg * 8 + i) * 64 + d]; GS[(seg * 8 + i) * 64 + d] = run; }
        SEG[seg * 64 + d] = run;
        __syncthreads();
        float pre = 0.f;
        for (int s = 0; s < seg; ++s) pre += SEG[s * 64 + d];
#pragma unroll
        for (int i = 0; i < 8; ++i) GS[(seg * 8 + i) * 64 + d] += pre; }
    __syncthreads();
}
__device__ __forceinline__ void load_v_image(LAS unsigned char* lds, const bf16* PE, size_t m0, int h) {
    const int tid = threadIdx.x, t = tid >> 3, vg = tid & 7;
    const bf16* src = PE + (m0 + t) * NE_BF + 512 + h * 128 + vg * 16;
    const v4u a = *(const v4u*)src, b = *(const v4u*)(src + 8);
    *(LAS v4u*)(lds + L_V + tr_off(t, vg * 16)) = a; *(LAS v4u*)(lds + L_V + tr_off(t, vg * 16 + 8)) = b;
}
__device__ __forceinline__ void g1_phase(LAS unsigned char* lds, const bf16* PE, const float* TE, const float* Wg, const float* bg, float* U, float* DEC) {
    const int tid = threadIdx.x, lane = tid & 63, r32 = lane & 31, hi = lane >> 5; const int wid = __builtin_amdgcn_readfirstlane(tid >> 6);
    LAS float* GS = (LAS float*)(lds + L_GS); LAS float* SEG = (LAS float*)(lds + L_SEG);
    for (int ch = blockIdx.x; ch < 2048; ch += gridDim.x) {
        const int bh = ch >> 6, n = ch & 63, b = bh >> 2, h = bh & 3; const size_t m0 = (size_t)b * SEQ + n * 64;
        gates(lds, TE, Wg, bg, m0, h);
        { const int t = tid >> 3, dg = tid & 7;
            const v4u kv = *(const v4u*)(PE + (m0 + t) * NE_BF + 256 + h * 64 + dg * 8);
            float ke[8];
#pragma unroll
            for (int e = 0; e < 8; ++e) { const int d = dg * 8 + e; float gl = 0.f;
#pragma unroll
                for (int s = 0; s < 8; ++s) gl += SEG[s * 64 + d];
                const unsigned w = (e & 1) ? (kv[e >> 1] >> 16) : (kv[e >> 1] & 0xffffu);
                ke[e] = bf2f((unsigned short)w) * expf(gl - GS[t * 64 + d]); }
            v4u o; o.x = cvtpk(ke[0], ke[1]); o.y = cvtpk(ke[2], ke[3]); o.z = cvtpk(ke[4], ke[5]); o.w = cvtpk(ke[6], ke[7]);
            *(LAS v4u*)(lds + L_KD + tr_off(t, dg * 8)) = o; }
        load_v_image(lds, PE, m0, h);
        if (tid < 64) { float gl = 0.f;
#pragma unroll
            for (int s = 0; s < 8; ++s) gl += SEG[s * 64 + tid];
            DEC[(size_t)ch * 64 + tid] = expf(gl); }
        __syncthreads();
        { const int mt = wid & 1, nt = wid >> 1; const int q = (lane & 15) >> 2, p = lane & 3, blk = (lane >> 4) & 1;
            const unsigned lb = (unsigned)(size_t)lds, ro = (8 * hi + q) * 64 + blk * 32 + p * 8;
            f32x16 acc;
#pragma unroll
            for (int r = 0; r < 16; ++r) acc[r] = 0.f;
#pragma unroll
            for (int ks = 0; ks < 4; ++ks) {
                const unsigned aa = lb + L_KD + (mt * 4 + ks) * 1024 + ro, ba = lb + L_V + (nt * 4 + ks) * 1024 + ro;
                const bf16x8 af = cat(trr(aa), trr(aa + 256)), bfr = cat(trr(ba), trr(ba + 256));
                acc = __builtin_amdgcn_mfma_f32_32x32x16_bf16(af, bfr, acc, 0, 0, 0);
            }
            float* Uo = U + (size_t)ch * 8192 + nt * 32 + r32;
#pragma unroll
            for (int r = 0; r < 16; ++r) Uo[(size_t)(mt * 32 + crow(r, hi)) * 128] = acc[r]; }
        __syncthreads();
    }
}
__device__ __forceinline__ void g2_phase(const float* U, const float* DEC, bf16* SP) {
    for (int gid = blockIdx.x * 512 + threadIdx.x; gid < 131072; gid += gridDim.x * 512) {
        const int bh = gid >> 12, d = (gid >> 6) & 63, v2 = gid & 63;
        f32x2 S = {0.f, 0.f};
#pragma unroll 8
        for (int n = 0; n < 64; ++n) { const size_t ch = (size_t)bh * 64 + n; const size_t off = (ch * 64 + d) * 128 + 2 * v2;
            const f32x2 u = *(const f32x2*)(U + off); const float dc = DEC[ch * 64 + d];
            *(unsigned*)(SP + off) = pk2(S.x, S.y);
            S = S * dc + u; }
    }
}
__device__ __forceinline__ void g3_phase(LAS unsigned char* lds, const bf16* PE, const float* TE, const float* Wg, const float* bg, const bf16* SP, const float* gn, bf16* OMIX) {
    const int tid = threadIdx.x, lane = tid & 63, r32 = lane & 31, hi = lane >> 5; const int wid = __builtin_amdgcn_readfirstlane(tid >> 6);
    LAS float* GS = (LAS float*)(lds + L_GS); LAS float* SSQ = (LAS float*)(lds + L_SSQ);
    for (int ch = blockIdx.x; ch < 2048; ch += gridDim.x) {
        const int bh = ch >> 6, n = ch & 63, b = bh >> 2, h = bh & 3; const size_t m0 = (size_t)b * SEQ + n * 64;
        gates(lds, TE, Wg, bg, m0, h);
        { const int t = tid >> 3, dg = tid & 7;
            const v4u qv = *(const v4u*)(PE + (m0 + t) * NE_BF + h * 64 + dg * 8), kv = *(const v4u*)(PE + (m0 + t) * NE_BF + 256 + h * 64 + dg * 8);
            float qd[8], kd[8];
#pragma unroll
            for (int e = 0; e < 8; ++e) { const float g = GS[t * 64 + dg * 8 + e];
                const unsigned wq = (e & 1) ? (qv[e >> 1] >> 16) : (qv[e >> 1] & 0xffffu), wk = (e & 1) ? (kv[e >> 1] >> 16) : (kv[e >> 1] & 0xffffu);
                qd[e] = bf2f((unsigned short)wq) * 0.125f * expf(g); kd[e] = bf2f((unsigned short)wk) * expf(-g); }
            v4u o; o.x = cvtpk(qd[0], qd[1]); o.y = cvtpk(qd[2], qd[3]); o.z = cvtpk(qd[4], qd[5]); o.w = cvtpk(qd[6], qd[7]);
            *(LAS v4u*)(lds + L_QD + dg * 1024 + t * 16) = o;
            o.x = cvtpk(kd[0], kd[1]); o.y = cvtpk(kd[2], kd[3]); o.z = cvtpk(kd[4], kd[5]); o.w = cvtpk(kd[6], kd[7]);
            *(LAS v4u*)(lds + L_KD + dg * 1024 + t * 16) = o; }
        load_v_image(lds, PE, m0, h);
        { const int d = tid >> 3, vg = tid & 7; const bf16* src = SP + ((size_t)ch * 64 + d) * 128 + vg * 16;
            const v4u a = *(const v4u*)src, b2 = *(const v4u*)(src + 8);
            *(LAS v4u*)(lds + L_S + tr_off(d, vg * 16)) = a; *(LAS v4u*)(lds + L_S + tr_off(d, vg * 16 + 8)) = b2; }
        __syncthreads();
        const int it = wid & 1, nt = wid >> 1; const int q = (lane & 15) >> 2, p = lane & 3, blk = (lane >> 4) & 1;
        const unsigned lb = (unsigned)(size_t)lds;
        f32x16 acc;
#pragma unroll
        for (int r = 0; r < 16; ++r) acc[r] = 0.f;
#pragma unroll
        for (int ks = 0; ks < 4; ++ks) {
            const bf16x8 af = *(const LAS bf16x8*)(lds + L_QD + (2 * ks + hi) * 1024 + (32 * it + r32) * 16);
            const unsigned ba = lb + L_S + (nt * 4 + ks) * 1024 + (8 * hi + q) * 64 + blk * 32 + p * 8;
            const bf16x8 bfr = cat(trr(ba), trr(ba + 256));
            acc = __builtin_amdgcn_mfma_f32_32x32x16_bf16(af, bfr, acc, 0, 0, 0);
        }
        for (int jt = 0; jt <= it; ++jt) {
            f32x16 X;
#pragma unroll
            for (int r = 0; r < 16; ++r) X[r] = 0.f;
#pragma unroll
            for (int ks = 0; ks < 4; ++ks) {
                const bf16x8 kf = *(const LAS bf16x8*)(lds + L_KD + (2 * ks + hi) * 1024 + (32 * jt + r32) * 16);
                const bf16x8 qf = *(const LAS bf16x8*)(lds + L_QD + (2 * ks + hi) * 1024 + (32 * it + r32) * 16);
                X = __builtin_amdgcn_mfma_f32_32x32x16_bf16(kf, qf, X, 0, 0, 0);
            }
            if (jt == it) {
#pragma unroll
                for (int r = 0; r < 16; ++r) if (crow(r, hi) > r32) X[r] = 0.f;
            }
#pragma unroll
            for (int s = 0; s < 2; ++s) {
                v4u w; w.x = cvtpk(X[8 * s + 0], X[8 * s + 1]); w.y = cvtpk(X[8 * s + 2], X[8 * s + 3]); w.z = cvtpk(X[8 * s + 4], X[8 * s + 5]); w.w = cvtpk(X[8 * s + 6], X[8 * s + 7]);
                const bf16x8 pa = __builtin_bit_cast(bf16x8, w);
                const unsigned va = lb + L_V + (nt * 4 + 2 * jt + s) * 1024 + (4 * hi + q) * 64 + blk * 32 + p * 8;
                const bf16x8 vf = cat(trr(va), trr(va + 512));
                acc = __builtin_amdgcn_mfma_f32_32x32x16_bf16(pa, vf, acc, 0, 0, 0);
            }
        }
#pragma unroll
        for (int r = 0; r < 16; ++r) { float s = acc[r] * acc[r];
            s += __shfl_xor(s, 1); s += __shfl_xor(s, 2); s += __shfl_xor(s, 4); s += __shfl_xor(s, 8); s += __shfl_xor(s, 16);
            if (r32 == 0) SSQ[(32 * it + crow(r, hi)) * 4 + nt] = s; }
        __syncthreads();
        { const int v = nt * 32 + r32; const float gnv = gn[v];
#pragma unroll
            for (int r = 0; r < 16; ++r) { const int i = 32 * it + crow(r, hi); const f32x4 sq = *(const LAS f32x4*)(SSQ + i * 4);
                const float rstd = rsqrtf(((sq.x + sq.y) + (sq.z + sq.w)) * (1.f / 128.f) + EPS);
                const float g = bf2f(PE[(m0 + i) * NE_BF + 1024 + h * 128 + v]);
                OMIX[(m0 + i) * DM + h * 128 + v] = (bf16)f2bf(acc[r] * rstd * gnv * (g / (1.f + expf(-g)))); } }
        __syncthreads();
    }
}
}
__global__ void __launch_bounds__(512, 2) k_gla1(const bf16* PE, const float* TE, const float* Wg, const float* bg, float* U, float* DEC) {
    extern __shared__ __attribute__((aligned(16))) unsigned char lds[];
    gla::g1_phase((LAS unsigned char*)lds, PE, TE, Wg, bg, U, DEC);
}
__global__ void __launch_bounds__(512, 2) k_gla2(const float* U, const float* DEC, bf16* SP) { gla::g2_phase(U, DEC, SP); }
__global__ void __launch_bounds__(512, 2) k_gla3(const bf16* PE, const float* TE, const float* Wg, const float* bg, const bf16* SP, const float* gn, bf16* OMIX) {
    extern __shared__ __attribute__((aligned(16))) unsigned char lds[];
    gla::g3_phase((LAS unsigned char*)lds, PE, TE, Wg, bg, SP, gn, OMIX);
}

namespace dsa {
typedef short bf16x8 __attribute__((ext_vector_type(8)));
typedef short s16x4 __attribute__((ext_vector_type(4)));
constexpr float L2E = 1.4426950408889634f;
constexpr int WAVE_LDS = 17920;
constexpr int L_WAVE = 0, L_T5 = 8 * WAVE_LDS, L_LUT = L_T5 + 2048, LDS_BYTES = L_LUT + 128;
constexpr size_t SCR_QL = 0, SCR_OL = 131072, SCR_SC = 262144, SCR_BYTES = 524288;
__device__ __forceinline__ s16x4 trr(unsigned addr) { s16x4 r; asm volatile("ds_read_b64_tr_b16 %0, %1" : "=&v"(r) : "v"(addr) : "memory"); return r; }
__device__ __forceinline__ bf16x8 cat(s16x4 a, s16x4 b) { return (bf16x8){a[0], a[1], a[2], a[3], b[0], b[1], b[2], b[3]}; }
__device__ __forceinline__ int fsw(int r) { return ((r & 7) << 1) | ((r >> 3) & 1); }
__device__ __forceinline__ int pos(int row, int c) { return row * 512 + ((c ^ fsw(row & 15)) << 4); }
__device__ __forceinline__ int wave_isum(int v) {
#pragma unroll
    for (int o = 1; o < 64; o <<= 1) v += __shfl_xor(v, o);
    return v;
}

__device__ __forceinline__ int select_row(const float* __restrict__ scrow, int t, LAS int* list, LAS unsigned* hist, LAS float* cand, int lane) {
    const int n = t + 1;
    if (n <= 256) {
#pragma unroll
        for (int j = 0; j < 4; ++j) { const int s = lane + 64 * j; list[s] = s <= t ? s : -1; }
        return n;
    }
    float x[64];
    float lo = INFINITY, hi = -INFINITY;
#pragma unroll
    for (int j = 0; j < 64; ++j) { const int s = lane + 64 * j; const bool v = s <= t; x[j] = v ? scrow[s] : -INFINITY; if (v) { lo = fminf(lo, x[j]); hi = fmaxf(hi, x[j]); } }
#pragma unroll
    for (int o = 1; o < 64; o <<= 1) { lo = fminf(lo, __shfl_xor(lo, o)); hi = fmaxf(hi, __shfl_xor(hi, o)); }
    const float scale = hi > lo ? 1023.0f / (hi - lo) : 0.f;
#pragma unroll
    for (int j = 0; j < 16; ++j) hist[lane + 64 * j] = 0u;
#pragma unroll
    for (int j = 0; j < 64; ++j) { if (lane + 64 * j <= t) { int b = (int)((x[j] - lo) * scale); b = b > 1023 ? 1023 : b; __hip_atomic_fetch_add(hist + b, 1u, __ATOMIC_RELAXED, __HIP_MEMORY_SCOPE_WORKGROUP); } }
    unsigned hb[16]; int cl = 0;
#pragma unroll
    for (int j = 0; j < 4; ++j) { const v4u h4 = *(const LAS v4u*)(hist + 16 * lane + 4 * j); hb[4 * j] = h4.x; hb[4 * j + 1] = h4.y; hb[4 * j + 2] = h4.z; hb[4 * j + 3] = h4.w; cl += (int)(h4.x + h4.y + h4.z + h4.w); }
    int suf = cl;
#pragma unroll
    for (int o = 1; o < 64; o <<= 1) { const int y = __shfl_down(suf, o); if (lane + o < 64) suf += y; }
    const unsigned long long bal = __ballot(suf >= 256);
    const int Lt = 63 - __builtin_clzll(bal);
    int Tb = 0, above = 0;
    { int cum = suf - cl, found = 0;
#pragma unroll
        for (int b = 15; b >= 0; --b) { if (!found) { if (cum + (int)hb[b] >= 256) { Tb = 16 * lane + b; above = cum; found = 1; } else cum += (int)hb[b]; } }
    }
    Tb = __shfl(Tb, Lt); above = __shfl(above, Lt);
    const int r = 256 - above;
    int ccount = 0;
#pragma unroll
    for (int j = 0; j < 64; ++j) {
        bool isc = false;
        if (lane + 64 * j <= t) { int b = (int)((x[j] - lo) * scale); b = b > 1023 ? 1023 : b; isc = (b == Tb); }
        const unsigned long long bm = __ballot(isc);
        if (bm) { const int p = ccount + __builtin_amdgcn_mbcnt_hi((unsigned)(bm >> 32), __builtin_amdgcn_mbcnt_lo((unsigned)bm, 0u)); if (isc && p < 64) cand[p] = x[j]; ccount += __builtin_popcountll(bm); }
    }
    float tau; int cgt;
    if (ccount <= 64) {
        const float mine = lane < ccount ? cand[lane] : -INFINITY;
        int gt = 0, ge = 0;
        for (int j = 0; j < ccount; ++j) { const float y = __shfl(mine, j); gt += y > mine ? 1 : 0; ge += y >= mine ? 1 : 0; }
        const unsigned long long ok = __ballot(lane < ccount && gt < r && r <= ge);
        const int src = __builtin_ctzll(ok);
        tau = __shfl(mine, src); cgt = __shfl(gt, src);
    } else {
        unsigned key = 0u;
        for (int bit = 31; bit >= 0; --bit) {
            const unsigned cnd = key | (1u << bit); int c = 0;
#pragma unroll
            for (int j = 0; j < 64; ++j) { if (lane + 64 * j <= t) { int b = (int)((x[j] - lo) * scale); b = b > 1023 ? 1023 : b; c += (b == Tb && ord_key(x[j]) >= cnd) ? 1 : 0; } }
            if (wave_isum(c) >= r) key = cnd;
        }
        const unsigned ub = (key & 0x80000000u) ? (key & 0x7fffffffu) : ~key;
        tau = __builtin_bit_cast(float, ub);
        int c = 0;
#pragma unroll
        for (int j = 0; j < 64; ++j) { if (lane + 64 * j <= t) { int b = (int)((x[j] - lo) * scale); b = b > 1023 ? 1023 : b; c += (b == Tb && x[j] > tau) ? 1 : 0; } }
        cgt = wave_isum(c);
    }
    int ngt_l = 0, neq_l = 0;
#pragma unroll
    for (int j = 0; j < 64; ++j) { ngt_l += x[j] > tau ? 1 : 0; neq_l += x[j] == tau ? 1 : 0; }
    const int req = 256 - (above + cgt);
    const int neq = wave_isum(neq_l);
    if (neq == req) {
        const int mycnt = ngt_l + neq_l; int inc = mycnt;
#pragma unroll
        for (int o = 1; o < 64; o <<= 1) { const int y = __shfl_up(inc, o); if (lane >= o) inc += y; }
        int p = inc - mycnt;
#pragma unroll
        for (int j = 0; j < 64; ++j) { if (x[j] >= tau) { list[p] = lane + 64 * j; ++p; } }
    } else {
        int base = 0, taken = 0;
#pragma unroll
        for (int j = 0; j < 64; ++j) {
            const bool g = x[j] > tau, e = x[j] == tau;
            const unsigned long long em = __ballot(e);
            const int erank = __builtin_amdgcn_mbcnt_hi((unsigned)(em >> 32), __builtin_amdgcn_mbcnt_lo((unsigned)em, 0u));
            const bool sel = g || (e && taken + erank < req);
            const unsigned long long sm = __ballot(sel);
            if (sel) list[base + __builtin_amdgcn_mbcnt_hi((unsigned)(sm >> 32), __builtin_amdgcn_mbcnt_lo((unsigned)sm, 0u))] = lane + 64 * j;
            base += __builtin_popcountll(sm); taken += __builtin_popcountll(em);
        }
    }
    return 256;
}

__device__ __forceinline__ void phase(LAS unsigned char* lds, const bf16* PO, const float* TO, const bf16* C, const bf16* WUKT, const bf16* WUVT, const float* t5, unsigned char* scratch, bf16* OMIX) {
    const int tid = threadIdx.x, lane = tid & 63, l15_ = lane & 15, g_ = lane >> 4; const int wid = __builtin_amdgcn_readfirstlane(tid >> 6);
    const int bx = blockIdx.x, G = gridDim.x; const int vcu = (G % 8 == 0) ? (bx % 8) * (G / 8) + bx / 8 : bx;
    LAS float* t5l = (LAS float*)(lds + L_T5); LAS unsigned char* lut = lds + L_LUT;
    LAS unsigned char* wl = lds + L_WAVE + wid * WAVE_LDS;
    LAS int* list = (LAS int*)(wl + 16384); LAS float* cand = (LAS float*)(wl + 16384 + 1024);
    unsigned char* scr = scratch + (size_t)bx * SCR_BYTES;
    bf16* QL = (bf16*)(scr + SCR_QL); bf16* OL = (bf16*)(scr + SCR_OL); float* SC = (float*)(scr + SCR_SC);
    t5l[tid] = t5[tid] * L2E;
    if (tid < 128) lut[tid] = (unsigned char)t5_bucket(tid);
    __syncthreads();
    for (int v = vcu; v < 256; v += G) {
        const int b = v >> 5, jj = v & 31;
#pragma unroll 1
        for (int ti = 0; ti < 8; ++ti) {
            const int tq = 64 * (ti >> 1) + ((ti & 1) ? 63 - jj : jj);
            const int t0 = tq * 16; const size_t mb0 = (size_t)b * SEQ, m0 = mb0 + t0;
#pragma unroll 1
            for (int hq = 0; hq < 2; ++hq) { const int hh = 2 * wid + hq;
                int l15 = l15_, g = g_; asm volatile("" : "+v"(l15), "+v"(g));
                bf16x8 bq[2];
#pragma unroll
                for (int ks = 0; ks < 2; ++ks) bq[ks] = *(const bf16x8*)(PO + (m0 + l15) * NO_IN + hh * 64 + 32 * ks + 8 * g);
#pragma unroll 4
                for (int lt = 0; lt < 16; ++lt) {
                    const bf16* wp = WUKT + ((size_t)(hh * 256 + 16 * lt + l15)) * 64 + 8 * g;
                    f32x4 acc = {0.f, 0.f, 0.f, 0.f};
                    acc = __builtin_amdgcn_mfma_f32_16x16x32_bf16(*(const bf16x8*)wp, bq[0], acc, 0, 0, 0);
                    acc = __builtin_amdgcn_mfma_f32_16x16x32_bf16(*(const bf16x8*)(wp + 32), bq[1], acc, 0, 0, 0);
                    *(unsigned long long*)(QL + ((size_t)(l15 * 16 + hh)) * 256 + 16 * lt + 4 * g) = (unsigned long long)pg8::cvt_pk_bf16(acc[0], acc[1]) | ((unsigned long long)pg8::cvt_pk_bf16(acc[2], acc[3]) << 32);
                } }
            {
                int l15 = l15_, g = g_; asm volatile("" : "+v"(l15), "+v"(g));
                bf16x8 aq[8][2]; float wq[4][8];
#pragma unroll
                for (int hh = 0; hh < 8; ++hh)
#pragma unroll
                    for (int ks = 0; ks < 2; ++ks) aq[hh][ks] = *(const bf16x8*)(PO + (m0 + l15) * NO_IN + 1280 + hh * 64 + 32 * ks + 8 * g);
#pragma unroll
                for (int i = 0; i < 4; ++i)
#pragma unroll
                    for (int hh = 0; hh < 8; ++hh) wq[i][hh] = TO[(m0 + 4 * g + i) * 96 + 64 + hh] * (0.35355339059327373f * 0.125f);
                for (int kt = wid; kt <= tq; kt += 8) {
                    const bf16* kp = PO + (mb0 + 16 * kt + l15) * NO_IN + 1792 + 8 * g;
                    const bf16x8 bk0 = *(const bf16x8*)kp, bk1 = *(const bf16x8*)(kp + 32);
                    float sc[4] = {0.f, 0.f, 0.f, 0.f};
#pragma unroll
                    for (int hh = 0; hh < 8; ++hh) {
                        f32x4 acc = {0.f, 0.f, 0.f, 0.f};
                        acc = __builtin_amdgcn_mfma_f32_16x16x32_bf16(aq[hh][0], bk0, acc, 0, 0, 0);
                        acc = __builtin_amdgcn_mfma_f32_16x16x32_bf16(aq[hh][1], bk1, acc, 0, 0, 0);
#pragma unroll
                        for (int i = 0; i < 4; ++i) sc[i] += wq[i][hh] * fmaxf(acc[i], 0.f);
                    }
#pragma unroll
                    for (int i = 0; i < 4; ++i) SC[(size_t)(4 * g + i) * SEQ + 16 * kt + l15] = sc[i];
                }
            }
            __syncthreads();
#pragma unroll 1
            for (int rq = 0; rq < 2; ++rq) {
                int l15 = l15_, g = g_, lnv = lane; asm volatile("" : "+v"(l15), "+v"(g), "+v"(lnv));
                const int rw = 2 * wid + rq, t = t0 + rw;
                const int nsel = select_row(SC + (size_t)rw * SEQ, t, list, (LAS unsigned*)wl, cand, lnv);
                const int nch = (nsel + 31) >> 5;
                bf16x8 qf[8];
#pragma unroll
                for (int ks = 0; ks < 8; ++ks) qf[ks] = *(const bf16x8*)(QL + ((size_t)(rw * 16 + l15)) * 256 + 32 * ks + 8 * g);
                f32x4 o[16];
#pragma unroll
                for (int nt = 0; nt < 16; ++nt) o[nt] = (f32x4){0.f, 0.f, 0.f, 0.f};
                float mrun = -INFINITY, lsum = 0.f;
                const bf16* Cb = C + mb0 * 256;
                const unsigned wlb = (unsigned)(size_t)wl;
                const int q4 = l15 >> 2, p4 = lnv & 3;
                for (int c = 0; c < nch; ++c) {
                    asm volatile("s_waitcnt lgkmcnt(0)" ::: "memory");
#pragma unroll
                    for (int i = 0; i < 16; ++i) { const int row = 2 * i + (lnv >> 5); int id = list[32 * c + row]; id = id < 0 ? 0 : id;
                        __builtin_amdgcn_global_load_lds((const unsigned*)(Cb + (size_t)id * 256 + (((lnv & 31) ^ fsw(row & 15)) << 3)), (LAS unsigned*)(wl + i * 1024), 16, 0, 0); }
                    asm volatile("s_waitcnt vmcnt(0)" ::: "memory");
                    f32x4 st[2];
#pragma unroll
                    for (int kt = 0; kt < 2; ++kt) { f32x4 acc = {0.f, 0.f, 0.f, 0.f};
#pragma unroll
                        for (int ks = 0; ks < 8; ++ks) { const bf16x8 a = *(const LAS bf16x8*)(wl + pos(16 * kt + l15, 4 * ks + g)); acc = __builtin_amdgcn_mfma_f32_16x16x32_bf16(a, qf[ks], acc, 0, 0, 0); }
                        st[kt] = acc; }
                    float cm = -INFINITY;
#pragma unroll
                    for (int kt = 0; kt < 2; ++kt) { const v4u id4 = *(const LAS v4u*)(list + 32 * c + 16 * kt + 4 * g);
#pragma unroll
                        for (int i = 0; i < 4; ++i) { const int id = (int)id4[i]; int dist = t - id; dist = dist < 0 ? 0 : dist; const int bk = dist < 128 ? (int)lut[dist] : 31;
                            const float s = id >= 0 ? st[kt][i] * (0.125f * L2E) + t5l[bk * 16 + l15] : -INFINITY; st[kt][i] = s; cm = fmaxf(cm, s); } }
                    cm = fmaxf(cm, __shfl_xor(cm, 16)); cm = fmaxf(cm, __shfl_xor(cm, 32));
                    const float mnew = fmaxf(mrun, cm), alpha = __builtin_amdgcn_exp2f(mrun - mnew); mrun = mnew;
                    float ps = 0.f;
#pragma unroll
                    for (int kt = 0; kt < 2; ++kt)
#pragma unroll
                        for (int i = 0; i < 4; ++i) { st[kt][i] = __builtin_amdgcn_exp2f(st[kt][i] - mnew); ps += st[kt][i]; }
                    lsum = lsum * alpha + ps;
                    if (__any(alpha != 1.0f)) {
#pragma unroll
                        for (int nt = 0; nt < 16; ++nt) o[nt] *= alpha;
                    }
                    v4u pw; pw.x = pg8::cvt_pk_bf16(st[0][0], st[0][1]); pw.y = pg8::cvt_pk_bf16(st[0][2], st[0][3]); pw.z = pg8::cvt_pk_bf16(st[1][0], st[1][1]); pw.w = pg8::cvt_pk_bf16(st[1][2], st[1][3]);
                    const bf16x8 pb = __builtin_bit_cast(bf16x8, pw);
                    const int r_lo = 4 * g + q4, r_hi = 16 + 4 * g + q4;
#pragma unroll
                    for (int nq = 0; nq < 4; ++nq) {
                        s16x4 lo4[4], hi4[4];
#pragma unroll
                        for (int k = 0; k < 4; ++k) { const int nt = 4 * nq + k; const int cch = 2 * nt + (p4 >> 1), sub = 8 * (p4 & 1);
                            lo4[k] = trr(wlb + pos(r_lo, cch) + sub); hi4[k] = trr(wlb + pos(r_hi, cch) + sub); }
                        asm volatile("s_waitcnt lgkmcnt(0)" ::: "memory"); __builtin_amdgcn_sched_barrier(0);
#pragma unroll
                        for (int k = 0; k < 4; ++k) o[4 * nq + k] = __builtin_amdgcn_mfma_f32_16x16x32_bf16(cat(lo4[k], hi4[k]), pb, o[4 * nq + k], 0, 0, 0);
                    }
                }
                lsum += __shfl_xor(lsum, 16); lsum += __shfl_xor(lsum, 32);
                const float inv = 1.f / lsum;
#pragma unroll
                for (int nt = 0; nt < 16; ++nt) { const f32x4 y = o[nt] * inv;
                    *(unsigned long long*)(OL + ((size_t)(rw * 16 + l15)) * 256 + 16 * nt + 4 * g) = (unsigned long long)pg8::cvt_pk_bf16(y[0], y[1]) | ((unsigned long long)pg8::cvt_pk_bf16(y[2], y[3]) << 32); }
            }
            __syncthreads();
#pragma unroll 1
            for (int hq = 0; hq < 2; ++hq) { const int hh = 2 * wid + hq;
                int l15 = l15_, g = g_; asm volatile("" : "+v"(l15), "+v"(g));
                bf16x8 ol[8];
#pragma unroll
                for (int ks = 0; ks < 8; ++ks) ol[ks] = *(const bf16x8*)(OL + ((size_t)(l15 * 16 + hh)) * 256 + 32 * ks + 8 * g);
#pragma unroll
                for (int dt = 0; dt < 4; ++dt) {
                    const bf16* wp = WUVT + ((size_t)(hh * 64 + 16 * dt + l15)) * 256 + 8 * g;
                    f32x4 acc = {0.f, 0.f, 0.f, 0.f};
#pragma unroll
                    for (int ks = 0; ks < 8; ++ks) acc = __builtin_amdgcn_mfma_f32_16x16x32_bf16(*(const bf16x8*)(wp + 32 * ks), ol[ks], acc, 0, 0, 0);
                    *(unsigned long long*)(OMIX + (m0 + l15) * DM + hh * 64 + 16 * dt + 4 * g) = (unsigned long long)pg8::cvt_pk_bf16(acc[0], acc[1]) | ((unsigned long long)pg8::cvt_pk_bf16(acc[2], acc[3]) << 32);
                } }
            __syncthreads();
        }
    }
}
__device__ __forceinline__ void cnorm_phase(const bf16* PO, const float* gk, bf16* C) {
    const int lane = threadIdx.x & 63, gw = blockIdx.x * 8 + (threadIdx.x >> 6), NGW = gridDim.x * 8;
    const f32x4 gv = *(const f32x4*)(gk + lane * 4);
    for (int m = gw; m < M; m += NGW) {
        const unsigned long long raw = *(const unsigned long long*)(PO + (size_t)m * NO_IN + 1024 + lane * 4);
        const float x0 = bf2f((unsigned short)raw), x1 = bf2f((unsigned short)(raw >> 16)), x2 = bf2f((unsigned short)(raw >> 32)), x3 = bf2f((unsigned short)(raw >> 48));
        const float rstd = rsqrtf(wave_sum(x0 * x0 + x1 * x1 + x2 * x2 + x3 * x3) * (1.f / 256.f) + EPS);
        *(unsigned long long*)(C + (size_t)m * 256 + lane * 4) = (unsigned long long)pk2(x0 * rstd * gv.x, x1 * rstd * gv.y) | ((unsigned long long)pk2(x2 * rstd * gv.z, x3 * rstd * gv.w) << 32);
    }
}
}
__global__ void __launch_bounds__(512, 2) k_dsa(const bf16* PO, const float* TO, const bf16* C, const bf16* WUKT, const bf16* WUVT, const float* t5, unsigned char* scratch, bf16* OMIX) {
    extern __shared__ __attribute__((aligned(16))) unsigned char lds[];
    dsa::phase((LAS unsigned char*)lds, PO, TO, C, WUKT, WUVT, t5, scratch, OMIX);
}
__global__ void __launch_bounds__(512, 2) k_cnorm(const bf16* PO, const float* gk, bf16* C) { dsa::cnorm_phase(PO, gk, C); }

template <class Epi> static void launch_gemm(hipStream_t st, const bf16* A, const bf16* Bt, int N, int K, void* p0, void* p1, const void* p2, int i0, int i1, int i2, int i3, int ldt, float f0) {
    GemmArgs a; memset(&a, 0, sizeof(a));
    a.A = A; a.Bt = Bt; a.Mr = M; a.N = N; a.K = K; a.p0 = p0; a.p1 = p1; a.p2 = p2; a.i0 = i0; a.i1 = i1; a.i2 = i2; a.i3 = i3; a.f0 = f0; a.pad1 = ldt;
    hipLaunchKernelGGL(k_gemm<Epi>, dim3(256), dim3(512), 131072, st, a);
}
extern "C" void kernel_launch(void* const* d_in, const int* in_sizes, int n_in, void* d_out, int out_size, void* d_ws, size_t ws_size, hipStream_t stream) {
    static int inited = 0;
    if (!inited) {
        if (n_in != 17 || ws_size < WS_END) { fprintf(stderr, "kernel_launch: unexpected n_in %d or ws_size %zu\n", n_in, ws_size); inited = -1; return; }
        hipFuncSetAttribute((const void*)k_gemm<pg8::EpiSwiglu>, hipFuncAttributeMaxDynamicSharedMemorySize, 131072);
        hipFuncSetAttribute((const void*)k_gemm<pg8::EpiResid>, hipFuncAttributeMaxDynamicSharedMemorySize, 131072);
        hipFuncSetAttribute((const void*)k_gemm<pg8::EpiProj>, hipFuncAttributeMaxDynamicSharedMemorySize, 131072);
        hipFuncSetAttribute((const void*)k_gla1, hipFuncAttributeMaxDynamicSharedMemorySize, gla::LDS_BYTES);
        hipFuncSetAttribute((const void*)k_dsa, hipFuncAttributeMaxDynamicSharedMemorySize, dsa::LDS_BYTES);
        hipFuncSetAttribute((const void*)k_gla3, hipFuncAttributeMaxDynamicSharedMemorySize, gla::LDS_BYTES);
        inited = 1;
    }
    if (inited < 0) return;
    const float* x = (const float*)d_in[0]; const float* norm_g = (const float*)d_in[1]; const float* ffn_w_in = (const float*)d_in[2]; const float* ffn_w_out = (const float*)d_in[3];
    const float* even_w_in = (const float*)d_in[4]; const float* gla_w_gate = (const float*)d_in[5]; const float* gla_b_gate = (const float*)d_in[6]; const float* gla_norm_g = (const float*)d_in[7];
    const float* fox_b_f = (const float*)d_in[8]; const float* even_w_out = (const float*)d_in[9]; const float* odd_w_in = (const float*)d_in[10]; const float* kv_norm_g = (const float*)d_in[11];
    const float* w_uk = (const float*)d_in[12]; const float* w_uv = (const float*)d_in[13]; const float* odd_w_out = (const float*)d_in[14]; const float* t5 = (const float*)d_in[15]; const float* final_g = (const float*)d_in[16];
    unsigned char* ws = (unsigned char*)d_ws; float* X = (float*)d_out;
    bf16* HB = (bf16*)(ws + WS_HB); bf16* BIG = (bf16*)(ws + WS_BIG); float* TE = (float*)(ws + WS_TE); float* TO = (float*)(ws + WS_TO);
    float* F = (float*)(ws + WS_F); float* GK = (float*)(ws + WS_GK); float* ALPHA = (float*)(ws + WS_ALPHA); float* OG = (float*)(ws + WS_OG);
    bf16* C = (bf16*)(ws + WS_C); int* IDX = (int*)(ws + WS_IDX);
    bf16* WUKT = (bf16*)(ws + 83 * MiB); bf16* WUVT = (bf16*)(ws + 83 * MiB + 524288); unsigned char* DSCR = ws + WS_AUX + 16 * MiB;
    float* GU = (float*)(ws + WS_AUX); bf16* GSP = (bf16*)(ws + WS_AUX + 64 * MiB); float* GDEC = (float*)(ws + WS_AUX + 96 * MiB);
    bf16* WFI = (bf16*)(ws + WS_WFI); bf16* WFO = (bf16*)(ws + WS_WFO); bf16* WEI = (bf16*)(ws + WS_WEI); bf16* WEO = (bf16*)(ws + WS_WEO); bf16* WOI = (bf16*)(ws + WS_WOI); bf16* WOO = (bf16*)(ws + WS_WOO);
    ProArgs pa; memset(&pa, 0, sizeof(pa));
    for (int i = 0; i < 4; ++i) {
        pa.w[i] = WDesc{ffn_w_in + (size_t)i * DM * 2 * DFF, (bf16*)((unsigned char*)WFI + i * FI_BYTES), DM, 2 * DFF, 2 * DFF, 1};
        pa.w[4 + i] = WDesc{ffn_w_out + (size_t)i * DFF * DM, (bf16*)((unsigned char*)WFO + i * FO_BYTES), DFF, DM, DM, 0};
    }
    pa.w[8] = WDesc{even_w_in, WEI, DM, 3096, NE_IN, 2}; pa.w[9] = WDesc{even_w_out, WEO, DM, DM, DM, 0};
    pa.w[10] = WDesc{odd_w_in, WOI, DM, 1864, NO_IN, 3}; pa.w[11] = WDesc{odd_w_out, WOO, DM, DM, DM, 0};
    for (int i = 0; i < 16; ++i) {
        pa.w[12 + i] = WDesc{w_uk + (size_t)i * 64 * 256, WUKT + (size_t)i * 256 * 64, 64, 256, 256, 0};
        pa.w[28 + i] = WDesc{w_uv + (size_t)i * 256 * 64, WUVT + (size_t)i * 64 * 256, 256, 64, 64, 0};
    }
    hipLaunchKernelGGL(k_prologue, dim3(1024), dim3(256), 0, stream, pa);
    auto norm = [&](const float* src, const float* g) { hipLaunchKernelGGL(k_norm<false>, dim3(256), dim3(512), 0, stream, src, g, HB, (float*)nullptr); };
    auto ffn = [&](int idx, const float* base) {
        launch_gemm<pg8::EpiSwiglu>(stream, HB, (bf16*)((unsigned char*)WFI + idx * FI_BYTES), 2 * DFF, DM, BIG, nullptr, nullptr, DFF, 0, 0, 0, 0, 0.f);
        launch_gemm<pg8::EpiResid>(stream, BIG, (bf16*)((unsigned char*)WFO + idx * FO_BYTES), DM, DFF, X, nullptr, base, DM, 0, 0, 0, 0, 0.5f);
    };
    norm(x, norm_g + 0 * DM); ffn(0, x);
    norm(X, norm_g + 1 * DM);
    launch_gemm<pg8::EpiProj>(stream, HB, WEI, NE_IN, DM, BIG, TE, nullptr, NE_BF, 12, 12, 1, 32, 0.f);
    hipLaunchKernelGGL(k_gla1, dim3(256), dim3(512), gla::LDS_BYTES, stream, BIG, TE, gla_w_gate, gla_b_gate, GU, GDEC);
    hipLaunchKernelGGL(k_gla2, dim3(256), dim3(512), 0, stream, GU, GDEC, GSP);
    hipLaunchKernelGGL(k_gla3, dim3(256), dim3(512), gla::LDS_BYTES, stream, BIG, TE, gla_w_gate, gla_b_gate, GSP, gla_norm_g, HB);
    hipLaunchKernelGGL(k_fox_scan, dim3(64), dim3(64), 0, stream, TE, fox_b_f, F);
    hipLaunchKernelGGL(k_fox, dim3(256), dim3(512), fox::LDS_BYTES, stream, BIG, F, HB);
    launch_gemm<pg8::EpiResid>(stream, HB, WEO, DM, DM, X, nullptr, X, DM, 0, 0, 0, 0, 1.0f);
    norm(X, norm_g + 2 * DM); ffn(1, X);
    norm(X, norm_g + 3 * DM); ffn(2, X);
    norm(X, norm_g + 4 * DM);
    launch_gemm<pg8::EpiProj>(stream, HB, WOI, NO_IN, DM, BIG, TO, nullptr, NO_IN, 8, 7, 3, 96, 0.f);
    hipLaunchKernelGGL(k_cnorm, dim3(256), dim3(512), 0, stream, BIG, kv_norm_g, C);
    hipLaunchKernelGGL(k_dsa, dim3(256), dim3(512), dsa::LDS_BYTES, stream, BIG, TO, C, WUKT, WUVT, t5, DSCR, HB);
    launch_gemm<pg8::EpiResid>(stream, HB, WOO, DM, DM, X, nullptr, X, DM, 0, 0, 0, 0, 1.0f);
    norm(X, norm_g + 5 * DM); ffn(3, X);
    hipLaunchKernelGGL(k_norm<true>, dim3(256), dim3(512), 0, stream, X, final_g, (bf16*)nullptr, X);
}
```

```cpp
#include <hip/hip_runtime.h>
#include <cstdio>
#include <cstdint>
#include <cstring>
namespace pg8 {
#define PG8_LAS __attribute__((address_space(3)))
typedef unsigned short bf16_t;
typedef short bf16x8 __attribute__((ext_vector_type(8)));
typedef float f32x4 __attribute__((ext_vector_type(4)));
typedef unsigned u32x4 __attribute__((ext_vector_type(4)));
constexpr int BM = 256, BK = 64, HALF = 128, HTB = HALF * BK * 2  , STAGE_BYTES = 8 * HTB, NXCD = 8, WGM = 8;

__host__ __device__ __forceinline__ int lds_byte(int r, int c) { const int st = (r >> 4) * 2 + (c >> 5), rr = r & 15, cc = c & 31, ob = rr * 64 + cc * 2; return st * 1024 + (ob ^ (((ob >> 9) & 1) << 5)); }
__host__ __device__ __forceinline__ void stage_rc(int b, int& R, int& C) { const int st = b / 1024, sb = b % 1024, swz = sb ^ (((sb >> 9) & 1) << 5); R = (st >> 1) * 16 + swz / 64; C = (st & 1) * 32 + (swz % 64) / 2; }
__host__ __device__ __forceinline__ int perm32(int rho) { const int n = rho >> 4, i = rho & 15; return 8 * (i >> 2) + 4 * n + (i & 3); }

struct Unit { int pm, pn, ord; };
struct Gemm { const bf16_t* A; const bf16_t* Bt; int M, N, K; };

struct StaticOrder {
    int nM, nN, nwg, G, c;
    __host__ __device__ void init(int M, int N, int G_, int c_) { nM = M / BM; nN = N / BM; nwg = nM * nN; G = G_; c = c_; }
    __host__ __device__ bool next(int i, Unit& u) const {
        const long L = (long)i * G + c; if (L >= nwg) return false;
        int wgid = (int)L; { const int q = nwg / NXCD, r = nwg % NXCD, xcd = wgid % NXCD, off = wgid / NXCD; wgid = (xcd < r ? xcd * (q + 1) : r * (q + 1) + (xcd - r) * q) + off; }
        const int nig = WGM * nN, gid = wgid / nig, fm = gid * WGM, gsz = (nM - fm) < WGM ? (nM - fm) : WGM;
        u.pm = fm + ((wgid % nig) % gsz); u.pn = (wgid % nig) / gsz; u.ord = i; return true;
    }
    __device__ __forceinline__ void a_ready(const Unit&) const {}
    __device__ __forceinline__ void done(const Unit&) const {}
};

typedef float f32x2_t __attribute__((ext_vector_type(2))); typedef __bf16 bf16x2_t __attribute__((ext_vector_type(2)));
__device__ __forceinline__ unsigned cvt_pk_bf16(float lo, float hi) { f32x2_t v = {lo, hi}; bf16x2_t b = __builtin_convertvector(v, bf16x2_t); return __builtin_bit_cast(unsigned, b); }
__device__ __forceinline__ float silu_f(float a) { return a * __builtin_amdgcn_rcpf(1.0f + __builtin_amdgcn_exp2f(-1.4426950408889634f * a)); }

template <class Epi, class Sched, bool ALIGN_EPI = false, bool SP2 = false>
__device__ __forceinline__ void gemm_phase(PG8_LAS unsigned char* lds, const Gemm g, const Sched& S, const Epi& E) {
    const int tid = threadIdx.x, wid = __builtin_amdgcn_readfirstlane(tid >> 6), lane = tid & 63, wr = wid >> 2, wc = wid & 3, fr = lane & 15, fq = lane >> 4;
    const int K = g.K, nt = K / BK;
    unsigned voffA[2], voffB[2];
#pragma unroll
    for (int i = 0; i < 2; ++i) { int R, C; stage_rc(tid * 16 + i * 8192, R, C); const int Rb = Epi::PERM ? ((R & ~31) + perm32(R & 31)) : R;
        voffA[i] = (unsigned)(R * K + C) * 2u; voffB[i] = (unsigned)(Rb * K + C) * 2u; }
    const size_t kstep = (size_t)(BK * 2);
    const size_t hstep = (size_t)HALF * K * 2;
    const size_t tstep = 2 * hstep;
    const unsigned ldsw = (unsigned)wid * 1024u;
    const int aoff = lds_byte(wr * 64 + fr, fq * 8), boff = lds_byte(wc * 32 + fr, fq * 8);
#define PG8_SA(b, h) (((b) * 2 + (h)) * HTB)
#define PG8_SB(b, h) ((4 + (b) * 2 + (h)) * HTB)
#define PG8_STAGE(bufoff, gbase, voff) do { _Pragma("unroll") for (int _i = 0; _i < 2; ++_i) \
        __builtin_amdgcn_global_load_lds((const unsigned*)((const char*)(gbase) + (voff)[_i]), (PG8_LAS unsigned*)(lds + (bufoff) + ldsw + _i * 8192), 16, 0, 0); } while (0)
#define PG8_LDA(dst, b, h) do { _Pragma("unroll") for (int m = 0; m < 4; ++m) _Pragma("unroll") for (int k = 0; k < 2; ++k) dst[m][k] = *(const PG8_LAS bf16x8*)(lds + PG8_SA(b, h) + aoff + m * 2048 + k * 1024); } while (0)
#define PG8_LDB(dst, b, h) do { _Pragma("unroll") for (int n = 0; n < 2; ++n) _Pragma("unroll") for (int k = 0; k < 2; ++k) dst[n][k] = *(const PG8_LAS bf16x8*)(lds + PG8_SB(b, h) + boff + n * 2048 + k * 1024); } while (0)
#define PG8_MMA(ai, bj, At, Bt) do { __builtin_amdgcn_s_setprio(1); _Pragma("unroll") for (int m = 0; m < 4; ++m) _Pragma("unroll") for (int n = 0; n < 2; ++n) _Pragma("unroll") for (int k = 0; k < 2; ++k) \
        acc[ai][bj][m][n] = __builtin_amdgcn_mfma_f32_16x16x32_bf16(Bt[n][k], At[m][k], acc[ai][bj][m][n], 0, 0, 0); __builtin_amdgcn_s_setprio(0); } while (0)
#define PG8_WAIT_V(n) asm volatile("s_waitcnt vmcnt(" #n ")" ::: "memory")
#define PG8_WAIT_L(n) asm volatile("s_waitcnt lgkmcnt(" #n ")" ::: "memory")
#define PG8_BAR __builtin_amdgcn_s_barrier()
#define PG8_SCHED __builtin_amdgcn_sched_barrier(0)
    Unit cur, nxt; int ui = 0;
    if (!S.next(0, cur)) return;
    f32x4 acc[2][2][4][2];
#pragma unroll
    for (int a = 0; a < 2; ++a)
#pragma unroll
        for (int b = 0; b < 2; ++b)
#pragma unroll
            for (int m = 0; m < 4; ++m)
#pragma unroll
                for (int n = 0; n < 2; ++n) acc[a][b][m][n] = (f32x4){0.f, 0.f, 0.f, 0.f};
    bf16x8 At[4][2], B0[2][2], B1[2][2];
    const char* cA = (const char*)g.A + (size_t)cur.pm * tstep; const char* cB = (const char*)g.Bt + (size_t)cur.pn * tstep;
    S.a_ready(cur);
    if constexpr (SP2) {
        PG8_STAGE(PG8_SB(0, 0), cB, voffB); PG8_STAGE(PG8_SB(0, 1), cB + hstep, voffB); PG8_STAGE(PG8_SA(0, 0), cA, voffA); PG8_STAGE(PG8_SA(0, 1), cA + hstep, voffA);
        if (wr == 1) PG8_BAR;
        PG8_WAIT_V(2); PG8_BAR;
        PG8_STAGE(PG8_SB(1, 0), cB + kstep, voffB); PG8_STAGE(PG8_SA(1, 0), cA + kstep, voffA); PG8_STAGE(PG8_SB(1, 1), cB + hstep + kstep, voffB);
        PG8_WAIT_V(6); PG8_BAR;
    } else {
        PG8_STAGE(PG8_SB(0, 0), cB, voffB); PG8_STAGE(PG8_SA(0, 0), cA, voffA); PG8_STAGE(PG8_SB(0, 1), cB + hstep, voffB); PG8_STAGE(PG8_SA(0, 1), cA + hstep, voffA);
        if (wr == 1) PG8_BAR;
        PG8_WAIT_V(4); PG8_BAR;
        PG8_STAGE(PG8_SB(1, 0), cB + kstep, voffB); PG8_STAGE(PG8_SA(1, 0), cA + kstep, voffA); PG8_STAGE(PG8_SB(1, 1), cB + hstep + kstep, voffB);
        PG8_WAIT_V(6); PG8_BAR;
    }
    for (;;) {
        const bool has_next = S.next(ui + 1, nxt);
        const char* nA = has_next ? (const char*)g.A + (size_t)nxt.pm * tstep : cA; const char* nB = has_next ? (const char*)g.Bt + (size_t)nxt.pn * tstep : cB;
        for (int t = 0; t < nt; t += 2) {
            const bool last = (t == nt - 2);
            const char* a1 = cA + (size_t)(t + 1) * kstep;
            const char* a2 = last ? nA : cA + (size_t)(t + 2) * kstep; const char* b2 = last ? nB : cB + (size_t)(t + 2) * kstep;
            const char* a3 = a2 + kstep; const char* b3 = b2 + kstep;
            if (last && has_next) S.a_ready(nxt);
            if constexpr (SP2) {
            PG8_LDB(B0, 0, 0); PG8_LDB(B1, 0, 1); PG8_SCHED; PG8_LDA(At, 0, 0); PG8_STAGE(PG8_SA(1, 1), a1 + hstep, voffA);
            PG8_WAIT_V(8); PG8_WAIT_L(0); PG8_BAR; PG8_MMA(0, 0, At, B0); PG8_MMA(0, 1, At, B1); PG8_BAR; PG8_SCHED;
            PG8_LDA(At, 0, 1); PG8_STAGE(PG8_SB(0, 0), b2, voffB); PG8_STAGE(PG8_SB(0, 1), b2 + hstep, voffB); PG8_STAGE(PG8_SA(0, 0), a2, voffA);
            PG8_WAIT_V(8); PG8_WAIT_L(0); PG8_BAR; PG8_MMA(1, 0, At, B0); PG8_MMA(1, 1, At, B1); PG8_BAR; PG8_SCHED;
            PG8_LDB(B0, 1, 0); PG8_LDB(B1, 1, 1); PG8_SCHED; PG8_LDA(At, 1, 0); PG8_STAGE(PG8_SA(0, 1), a2 + hstep, voffA);
            PG8_WAIT_V(8); PG8_WAIT_L(0); PG8_BAR; PG8_MMA(0, 0, At, B0); PG8_MMA(0, 1, At, B1); PG8_BAR; PG8_SCHED;
            PG8_LDA(At, 1, 1); PG8_STAGE(PG8_SB(1, 0), b3, voffB); PG8_STAGE(PG8_SB(1, 1), b3 + hstep, voffB); PG8_STAGE(PG8_SA(1, 0), a3, voffA);
            PG8_WAIT_V(8); PG8_WAIT_L(0); PG8_BAR; PG8_MMA(1, 0, At, B0); PG8_MMA(1, 1, At, B1); PG8_BAR; PG8_SCHED;
            } else {
            PG8_LDB(B0, 0, 0); PG8_SCHED; PG8_LDA(At, 0, 0); PG8_STAGE(PG8_SA(1, 1), a1 + hstep, voffA);
            PG8_WAIT_L(8); PG8_BAR; PG8_WAIT_L(0); PG8_MMA(0, 0, At, B0); PG8_BAR; PG8_SCHED;
            PG8_LDB(B1, 0, 1); PG8_STAGE(PG8_SB(0, 0), b2, voffB);
            PG8_BAR; PG8_WAIT_L(0); PG8_MMA(0, 1, At, B1); PG8_BAR;
            PG8_LDA(At, 0, 1); PG8_STAGE(PG8_SA(0, 0), a2, voffA);
            PG8_BAR; PG8_WAIT_L(0); PG8_MMA(1, 0, At, B0); PG8_BAR; PG8_SCHED;
            PG8_STAGE(PG8_SB(0, 1), b2 + hstep, voffB);
            PG8_WAIT_V(6); PG8_BAR; PG8_MMA(1, 1, At, B1); PG8_BAR;
            PG8_LDB(B0, 1, 0); PG8_SCHED; PG8_LDA(At, 1, 0); PG8_STAGE(PG8_SA(0, 1), a2 + hstep, voffA);
            PG8_WAIT_L(8); PG8_BAR; PG8_WAIT_L(0); PG8_MMA(0, 0, At, B0); PG8_BAR; PG8_SCHED;
            PG8_LDB(B1, 1, 1); PG8_STAGE(PG8_SB(1, 0), b3, voffB);
            PG8_BAR; PG8_WAIT_L(0); PG8_MMA(0, 1, At, B1); PG8_BAR;
            PG8_LDA(At, 1, 1); PG8_STAGE(PG8_SA(1, 0), a3, voffA);
            PG8_BAR; PG8_WAIT_L(0); PG8_MMA(1, 0, At, B0); PG8_BAR; PG8_SCHED;
            PG8_STAGE(PG8_SB(1, 1), b3 + hstep, voffB);
            PG8_WAIT_V(6); PG8_BAR; PG8_MMA(1, 1, At, B1); PG8_BAR;
            }
        }
        if constexpr (ALIGN_EPI) { if (wr == 0) PG8_BAR; }
        if constexpr (!Epi::AFTER_DRAIN) { E(acc, cur, wr, wc, fr, fq); S.done(cur); }
        if (!has_next) break;
#pragma unroll
        for (int a = 0; a < 2; ++a)
#pragma unroll
            for (int b = 0; b < 2; ++b)
#pragma unroll
                for (int m = 0; m < 4; ++m)
#pragma unroll
                    for (int n = 0; n < 2; ++n) acc[a][b][m][n] = (f32x4){0.f, 0.f, 0.f, 0.f};
        cur = nxt; cA = nA; cB = nB; ++ui;
        if constexpr (ALIGN_EPI) { if (wr == 1) PG8_BAR; }
    }
    PG8_WAIT_V(0);
    if constexpr (!ALIGN_EPI) { if (wr == 0) PG8_BAR; }
    PG8_BAR;
    if constexpr (Epi::AFTER_DRAIN) { E.fused(acc, cur, wr, wc, fr, fq, lds, wid, lane); S.done(cur); }
#undef PG8_SA
#undef PG8_SB
#undef PG8_STAGE
#undef PG8_LDA
#undef PG8_LDB
#undef PG8_MMA
#undef PG8_WAIT_V
#undef PG8_WAIT_L
#undef PG8_BAR
#undef PG8_SCHED
}
}
constexpr int BATCH = 8, SEQ = 4096, DM = 1024, M = BATCH * SEQ, DFF = 2816;
constexpr int NE_IN = 3328, NE_BF = 3072, NO_IN = 2048;
constexpr float EPS = 1e-6f;
typedef unsigned short bf16;
typedef unsigned v4u __attribute__((ext_vector_type(4)));
typedef float f32x4 __attribute__((ext_vector_type(4)));
#define LAS __attribute__((address_space(3)))
#define GAS __attribute__((address_space(1)))
constexpr size_t MiB = 1u << 20;
constexpr size_t WS_CTL = 0, WS_KMAX = 524288, WS_F = 1 * MiB;
constexpr size_t WS_WFI = 2 * MiB, WS_WFO = 46 * MiB, WS_WEI = 68 * MiB, WS_WEO = 75 * MiB, WS_WOI = 77 * MiB, WS_WOO = 81 * MiB;
constexpr size_t WS_WUK = 83 * MiB, WS_WUV = 83 * MiB + 524288;
constexpr size_t WS_HB = 84 * MiB;
constexpr size_t WS_BIG = 148 * MiB;
constexpr size_t WS_TE = WS_BIG + 192 * MiB, WS_TO = WS_BIG + 128 * MiB;
constexpr size_t WS_OMIX_ODD = WS_BIG + 132 * MiB;
constexpr size_t WS_AUX = 344 * MiB;
constexpr size_t WS_C = WS_AUX;
constexpr size_t WS_GU = WS_AUX, WS_GSP = WS_AUX + 64 * MiB, WS_GDEC = WS_AUX + 96 * MiB, WS_DSCR = WS_AUX + 16 * MiB;
constexpr size_t WS_OMIX_EVEN = WS_AUX + 100 * MiB, WS_SSQ = WS_AUX + 164 * MiB;
constexpr size_t WS_END = 512 * MiB;
constexpr size_t FI_BYTES = (size_t)2 * DFF * DM * 2, FO_BYTES = (size_t)DM * DFF * 2;

__device__ __forceinline__ unsigned f2bf(float f) { unsigned u = __builtin_bit_cast(unsigned, f); return (u + 0x7fffu + ((u >> 16) & 1u)) >> 16; }
__device__ __forceinline__ unsigned pk2(float lo, float hi) { return f2bf(lo) | (f2bf(hi) << 16); }
__device__ __forceinline__ float bf2f(unsigned short b) { return __builtin_bit_cast(float, (unsigned)b << 16); }
__device__ __forceinline__ float wave_sum(float v) {
#pragma unroll
    for (int o = 1; o < 64; o <<= 1) v += __shfl_xor(v, o);
    return v;
}
__device__ __forceinline__ float wave_max(float v) {
#pragma unroll
    for (int o = 1; o < 64; o <<= 1) v = fmaxf(v, __shfl_xor(v, o));
    return v;
}
__device__ __forceinline__ float log_sigmoid(float x) { return fminf(x, 0.f) - log1pf(expf(-fabsf(x))); }

namespace pg8 {
constexpr int RSTD_LDS_OFF = 131072;
__device__ __forceinline__ float row_rstd(const float* SSQ, int row, int fq) {
    const f32x4 p = *(const f32x4*)(SSQ + (size_t)row * 16 + 4 * fq);
    float s = (p.x + p.y) + (p.z + p.w);
    s += __shfl_xor(s, 16); s += __shfl_xor(s, 32);
    return rsqrtf(s * (1.f / 1024.f) + 1e-6f);
}
struct EpiSwiglu {
    static constexpr bool PERM = true, AFTER_DRAIN = false;
    unsigned char* ws;
    __device__ __forceinline__ void operator()(const f32x4 (&acc)[2][2][4][2], const Unit& u, int wr, int wc, int fr, int fq) const {
        bf16_t* O = (bf16_t*)(ws + WS_BIG); constexpr int ldc = DFF; const PG8_LAS float* tab = (const PG8_LAS float*)RSTD_LDS_OFF + u.ord * 256;
        int fqv = fq, frv = fr; asm volatile("" : "+v"(fqv), "+v"(frv));
        const int row0 = u.pm * BM + wr * 64 + frv, col0 = u.pn * HALF + wc * 32 + 8 * fqv;
#pragma unroll
        for (int ai = 0; ai < 2; ++ai)
#pragma unroll
            for (int m = 0; m < 4; ++m) { const int row = row0 + ai * HALF + m * 16; bf16_t* rowp = O + (size_t)row * ldc + col0;
                const float rs = tab[(row0 & 255) + ai * HALF + m * 16];
                const f32x4 a0 = acc[ai][0][m][0] * rs, a1 = acc[ai][0][m][1] * rs, b0 = acc[ai][1][m][0] * rs, b1 = acc[ai][1][m][1] * rs;
                u32x4 w; w.x = cvt_pk_bf16(silu_f(a0[0]) * b0[0], silu_f(a0[1]) * b0[1]); w.y = cvt_pk_bf16(silu_f(a0[2]) * b0[2], silu_f(a0[3]) * b0[3]);
                w.z = cvt_pk_bf16(silu_f(a1[0]) * b1[0], silu_f(a1[1]) * b1[1]); w.w = cvt_pk_bf16(silu_f(a1[2]) * b1[2], silu_f(a1[3]) * b1[3]);
                *(u32x4*)rowp = w; }
    }
};
struct EpiResid {
    static constexpr bool PERM = true, AFTER_DRAIN = false;
    unsigned char* ws; float scale;
    __device__ __forceinline__ void operator()(const f32x4 (&acc)[2][2][4][2], const Unit& u, int wr, int wc, int fr, int fq) const {
        bf16_t* XB = (bf16_t*)(ws + WS_HB); float* SSQ = (float*)(ws + WS_SSQ); constexpr int ldc = DM;
        int fqv = fq, frv = fr; asm volatile("" : "+v"(fqv), "+v"(frv));
        const int row0 = u.pm * BM + wr * 64 + frv, col0 = u.pn * BM + wc * 32 + 8 * fqv;
        u32x4 bv[2][4][2];
#pragma unroll
        for (int ai = 0; ai < 2; ++ai)
#pragma unroll
            for (int m = 0; m < 4; ++m)
#pragma unroll
                for (int bj = 0; bj < 2; ++bj) bv[ai][m][bj] = *(const u32x4*)(XB + (size_t)(row0 + ai * HALF + m * 16) * ldc + col0 + bj * HALF);
#pragma unroll
        for (int ai = 0; ai < 2; ++ai)
#pragma unroll
            for (int m = 0; m < 4; ++m) { const int row = row0 + ai * HALF + m * 16; bf16_t* rowp = XB + (size_t)row * ldc + col0; float s = 0.f;
#pragma unroll
                for (int bj = 0; bj < 2; ++bj) { const u32x4 b = bv[ai][m][bj]; const f32x4 a0 = acc[ai][bj][m][0] * scale, a1 = acc[ai][bj][m][1] * scale;
                    float y[8];
                    y[0] = __builtin_bit_cast(float, b.x << 16) + a0[0]; y[1] = __builtin_bit_cast(float, b.x & 0xffff0000u) + a0[1];
                    y[2] = __builtin_bit_cast(float, b.y << 16) + a0[2]; y[3] = __builtin_bit_cast(float, b.y & 0xffff0000u) + a0[3];
                    y[4] = __builtin_bit_cast(float, b.z << 16) + a1[0]; y[5] = __builtin_bit_cast(float, b.z & 0xffff0000u) + a1[1];
                    y[6] = __builtin_bit_cast(float, b.w << 16) + a1[2]; y[7] = __builtin_bit_cast(float, b.w & 0xffff0000u) + a1[3];
                    u32x4 w; w.x = cvt_pk_bf16(y[0], y[1]); w.y = cvt_pk_bf16(y[2], y[3]); w.z = cvt_pk_bf16(y[4], y[5]); w.w = cvt_pk_bf16(y[6], y[7]);
                    *(u32x4*)(rowp + bj * HALF) = w;
                    s += ((y[0] * y[0] + y[1] * y[1]) + (y[2] * y[2] + y[3] * y[3])) + ((y[4] * y[4] + y[5] * y[5]) + (y[6] * y[6] + y[7] * y[7])); }
                s += __shfl_xor(s, 16); s += __shfl_xor(s, 32);
                if (fqv == 0) SSQ[(size_t)row * 16 + u.pn * 4 + wc] = s; }
    }
};
struct EpiProj {
    static constexpr bool PERM = true, AFTER_DRAIN = false;
    unsigned char* ws; int ldc; int nbf; int tail_pn; size_t toff;
    __device__ __forceinline__ void operator()(const f32x4 (&acc)[2][2][4][2], const Unit& u, int wr, int wc, int fr, int fq) const {
        bf16_t* O = (bf16_t*)(ws + WS_BIG); float* T = (float*)(ws + toff); constexpr int ldt = 32, tail_wc = 1; const PG8_LAS float* tab = (const PG8_LAS float*)RSTD_LDS_OFF + u.ord * 256;
        int fqv = fq, frv = fr; asm volatile("" : "+v"(fqv), "+v"(frv));
        const int row0 = u.pm * BM + wr * 64 + frv, col0 = u.pn * BM + wc * 32 + 8 * fqv;
        const bool do_bf = u.pn < nbf, do_tail = (u.pn == tail_pn && wc < tail_wc);
#pragma unroll
        for (int ai = 0; ai < 2; ++ai)
#pragma unroll
            for (int m = 0; m < 4; ++m) { const int row = row0 + ai * HALF + m * 16; const float rs = tab[(row0 & 255) + ai * HALF + m * 16];
                if (do_bf) { bf16_t* rowp = O + (size_t)row * ldc + col0;
#pragma unroll
                    for (int bj = 0; bj < 2; ++bj) { const f32x4 v0 = acc[ai][bj][m][0] * rs, v1 = acc[ai][bj][m][1] * rs;
                        u32x4 w; w.x = cvt_pk_bf16(v0[0], v0[1]); w.y = cvt_pk_bf16(v0[2], v0[3]); w.z = cvt_pk_bf16(v1[0], v1[1]); w.w = cvt_pk_bf16(v1[2], v1[3]);
                        *(u32x4*)(rowp + bj * HALF) = w; } }
                if (do_tail) { float* rowp = T + (size_t)row * ldt + wc * 32 + 8 * fqv;
                    *(f32x4*)rowp = acc[ai][0][m][0] * rs; *(f32x4*)(rowp + 4) = acc[ai][0][m][1] * rs; } }
    }
};

}
struct WDesc { const float* src; bf16* dst; const float* gk; int K, Ns, Nd, kind; };
__device__ __forceinline__ int src_col(int kind, int n, int Ns) {
    if (kind == 1) { const int j = n >> 8, r = n & 255; return r < 128 ? 128 * j + r : DFF + 128 * j + (r - 128); }
    if (kind == 2) { if (n < 1536) return n; if (n < 3072) return n + 16; if (n < 3088) return 1536 + (n - 3072); if (n < 3096) return n; return -1; }
    if (kind == 3) { if (n < 1792) return n; if (n < 1800) return 1856 + (n - 1792); if (n < 1864) return 1792 + (n - 1800); return -1; }
    return n < Ns ? n : -1;
}
__device__ __forceinline__ void transpose_item(const WDesc& w, LAS float* scr, int item, int lane) {
    const int nblk = w.Nd / 32, kb = item / nblk, nb = item % nblk, k0 = 64 * kb, n0 = 32 * nb;
    const int sc = src_col(w.kind, n0 + (lane & 31), w.Ns);
    const int scc = sc >= 0 ? sc : 0; const float msk = sc >= 0 ? 1.f : 0.f;
    const float* sp = w.src + (size_t)(k0 + (lane >> 5)) * w.Ns + scc;
    float tv[32];
#pragma unroll
    for (int i = 0; i < 32; ++i) tv[i] = sp[(size_t)(2 * i) * w.Ns];
    if (w.gk) {
#pragma unroll
        for (int i = 0; i < 32; ++i) tv[i] *= w.gk[k0 + 2 * i + (lane >> 5)];
    }
#pragma unroll
    for (int i = 0; i < 32; ++i) scr[(2 * i + (lane >> 5)) * 33 + (lane & 31)] = tv[i] * msk;
    asm volatile("s_waitcnt lgkmcnt(0)" ::: "memory");
    const int c = lane & 7;
#pragma unroll
    for (int j = 0; j < 4; ++j) { const int n = (lane >> 3) + 8 * j; const LAS float* s = scr + (8 * c) * 33 + n;
        v4u o; o.x = pk2(s[0 * 33], s[1 * 33]); o.y = pk2(s[2 * 33], s[3 * 33]); o.z = pk2(s[4 * 33], s[5 * 33]); o.w = pk2(s[6 * 33], s[7 * 33]);
        *(v4u*)(w.dst + (size_t)(n0 + n) * w.K + k0 + 8 * c) = o; }
    asm volatile("s_waitcnt lgkmcnt(0)" ::: "memory");
}
__device__ __forceinline__ unsigned ord_key(float x) { const unsigned u = __builtin_bit_cast(unsigned, x); return (u & 0x80000000u) ? ~u : (u | 0x80000000u); }
__device__ __forceinline__ int t5_bucket(int dist) {
    if (dist < 16) return dist;
    const int large = 16 + (int)(logf((float)dist * (1.f / 16.f)) / 2.0794415416798357f * 16.f);
    return large < 31 ? large : 31;
}
namespace fox {
typedef short bf16x8 __attribute__((ext_vector_type(8)));
typedef short s16x4 __attribute__((ext_vector_type(4)));
typedef float f32x16 __attribute__((ext_vector_type(16)));
constexpr int PITCH = NE_BF;
constexpr float C2 = 0.125f * 1.4426950408889634f, L2E = 1.4426950408889634f;
constexpr int L_K = 0, L_V = 16384, L_NB = 32768, L_AL = 49152, L_MM = 50176, LDS_BYTES = 50432;
__device__ __forceinline__ int crow(int r, int hi) { return (r & 3) + 8 * (r >> 2) + 4 * hi; }
__device__ __forceinline__ unsigned cvtpk(float lo, float hi) { return pg8::cvt_pk_bf16(lo, hi); }

__device__ __forceinline__ void attn_unit(int b, int h, int qb, const bf16* PE, const float* F, const float* KMAX, bf16* OMIX, LAS unsigned char* lds) {
    const int tid = threadIdx.x, lane = tid & 63, r32 = lane & 31, hi = lane >> 5; const int wid = __builtin_amdgcn_readfirstlane(tid >> 6);
    const size_t rowbase = (size_t)b * SEQ; const int q0 = qb * 256;
    const bf16* Qw = PE + (rowbase + q0 + wid * 32) * PITCH + 1536 + h * 64;
    const bf16* Kh = PE + rowbase * PITCH + 2048 + h * 64; const bf16* Vh = Kh + 512;
    const float* Fr = F + (size_t)(b * 8 + h) * SEQ;
    LAS float* nb = (LAS float*)(lds + L_NB);
    LAS float* al = (LAS float*)(lds + L_AL) + wid * 32;
    const float Fq0 = Fr[q0];
    for (int s = tid; s < q0 + 256; s += 512) nb[s] = (Fq0 - Fr[s]) * L2E;
    bf16x8 qr[4];
#pragma unroll
    for (int d0 = 0; d0 < 4; ++d0) qr[d0] = *(const bf16x8*)(Qw + (size_t)r32 * PITCH + d0 * 16 + hi * 8);
    const int NT = (q0 + 256) / 64;
    float qkb;
    { float s2 = 0.f;
#pragma unroll
        for (int d0 = 0; d0 < 4; ++d0)
#pragma unroll
            for (int e = 0; e < 8; ++e) { const float qv = bf2f((unsigned short)qr[d0][e]); s2 += qv * qv; }
        s2 += __shfl_xor(s2, 32);
        qkb = C2 * sqrtf(s2) * sqrtf(KMAX[b * 8 + h]) * 1.001f + 38.0f; }
    LAS int* MM = (LAS int*)(lds + L_MM);
    const int qrow = q0 + wid * 32 + r32;
    const int wtop = (q0 + wid * 32 + 31) >> 6;
    const bf16* ksrc = Kh + (size_t)lane * PITCH + wid * 8;
    const bf16* vsrc = Vh + (size_t)(16 * (wid & 3) + (lane >> 2)) * PITCH + (wid >> 2) * 32 + (lane & 3) * 8;
    const int stg = wid * 1024 + lane * 16;
    v4u kreg = *(const v4u*)(ksrc + (size_t)(NT - 1) * 64 * PITCH), vreg = *(const v4u*)(vsrc + (size_t)(NT - 1) * 64 * PITCH);
    float mrun = -INFINITY, lrun = 0.f; f32x16 o0, o1;
#pragma unroll
    for (int r = 0; r < 16; ++r) { o0[r] = 0.f; o1[r] = 0.f; }
    const int vbl = ((lane >> 4) & 1) * 32 + (lane & 3) * 8 + (4 * hi + ((lane & 15) >> 2)) * 64;
    int it = 0;
    for (int t = NT - 1; t >= 0; --t, ++it) {
        const int slot = (it & 1) * 8192;
        *(LAS v4u*)(lds + L_K + slot + stg) = kreg; *(LAS v4u*)(lds + L_V + slot + stg) = vreg;
        __syncthreads();
        if (it > 0) { const LAS int* mf = MM + ((it - 1) & 1) * 8; const int allf = mf[0] & mf[1] & mf[2] & mf[3] & mf[4] & mf[5] & mf[6] & mf[7]; if (allf) break; }
        if (t > 0) { kreg = *(const v4u*)(ksrc + (size_t)(t - 1) * 64 * PITCH); vreg = *(const v4u*)(vsrc + (size_t)(t - 1) * 64 * PITCH); }
        if (t <= wtop) {
            f32x16 p0, p1;
#pragma unroll
            for (int r = 0; r < 16; ++r) { p0[r] = 0.f; p1[r] = 0.f; }
            const LAS unsigned char* kb = lds + L_K + slot + hi * 1024 + r32 * 16;
#pragma unroll
            for (int d0 = 0; d0 < 4; ++d0) {
                const bf16x8 b0 = *(const LAS bf16x8*)(kb + d0 * 2048), b1 = *(const LAS bf16x8*)(kb + d0 * 2048 + 512);
                p0 = __builtin_amdgcn_mfma_f32_32x32x16_bf16(b0, qr[d0], p0, 0, 0, 0);
                p1 = __builtin_amdgcn_mfma_f32_32x32x16_bf16(b1, qr[d0], p1, 0, 0, 0);
            }
            const LAS float* nbt = nb + t * 64 + 4 * hi;
#pragma unroll
            for (int g = 0; g < 4; ++g) { const f32x4 n0 = *(const LAS f32x4*)(nbt + 8 * g), n1 = *(const LAS f32x4*)(nbt + 32 + 8 * g);
#pragma unroll
                for (int e = 0; e < 4; ++e) { p0[4 * g + e] = p0[4 * g + e] * C2 + n0[e]; p1[4 * g + e] = p1[4 * g + e] * C2 + n1[e]; } }
            if (t * 64 + 63 > q0 + wid * 32) {
#pragma unroll
                for (int r = 0; r < 16; ++r) { const int kv = t * 64 + crow(r, hi); if (kv > qrow) p0[r] = -INFINITY; if (kv + 32 > qrow) p1[r] = -INFINITY; }
            }
            float rm = -INFINITY;
#pragma unroll
            for (int r = 0; r < 16; ++r) rm = fmaxf(rm, fmaxf(p0[r], p1[r]));
            rm = fmaxf(rm, __shfl_xor(rm, 32));
            const float mnew = fmaxf(mrun, rm);
            const float alpha = __builtin_amdgcn_exp2f(mrun - mnew);
            mrun = mnew;
            float sum = 0.f;
#pragma unroll
            for (int r = 0; r < 16; ++r) { p0[r] = __builtin_amdgcn_exp2f(p0[r] - mnew); p1[r] = __builtin_amdgcn_exp2f(p1[r] - mnew); sum += p0[r] + p1[r]; }
            lrun = lrun * alpha + sum;
            if (hi == 0) al[r32] = alpha;
            asm volatile("s_waitcnt lgkmcnt(0)" ::: "memory");
#pragma unroll
            for (int g = 0; g < 4; ++g) { const f32x4 a4 = *(const LAS f32x4*)(al + 8 * g + 4 * hi);
#pragma unroll
                for (int e = 0; e < 4; ++e) { o0[4 * g + e] *= a4[e]; o1[4 * g + e] *= a4[e]; } }
            bf16x8 pa[4];
#pragma unroll
            for (int k = 0; k < 2; ++k) {
                v4u w0, w1;
                w0.x = cvtpk(p0[8 * k + 0], p0[8 * k + 1]); w0.y = cvtpk(p0[8 * k + 2], p0[8 * k + 3]); w0.z = cvtpk(p0[8 * k + 4], p0[8 * k + 5]); w0.w = cvtpk(p0[8 * k + 6], p0[8 * k + 7]);
                w1.x = cvtpk(p1[8 * k + 0], p1[8 * k + 1]); w1.y = cvtpk(p1[8 * k + 2], p1[8 * k + 3]); w1.z = cvtpk(p1[8 * k + 4], p1[8 * k + 5]); w1.w = cvtpk(p1[8 * k + 6], p1[8 * k + 7]);
                pa[k] = __builtin_bit_cast(bf16x8, w0); pa[2 + k] = __builtin_bit_cast(bf16x8, w1);
            }
            const unsigned vb = (unsigned)(size_t)(lds + L_V + slot) + vbl;
#pragma unroll
            for (int d0 = 0; d0 < 2; ++d0) {
                s16x4 lo[4], hh[4];
#pragma unroll
                for (int ks = 0; ks < 4; ++ks) {
                    asm volatile("ds_read_b64_tr_b16 %0, %1 offset:%c2" : "=&v"(lo[ks]) : "v"(vb), "i"(d0 * 4096 + ks * 1024) : "memory");
                    asm volatile("ds_read_b64_tr_b16 %0, %1 offset:%c2" : "=&v"(hh[ks]) : "v"(vb), "i"(d0 * 4096 + ks * 1024 + 512) : "memory");
                }
                asm volatile("s_waitcnt lgkmcnt(0)" ::: "memory"); __builtin_amdgcn_sched_barrier(0);
#pragma unroll
                for (int ks = 0; ks < 4; ++ks) {
                    const bf16x8 vf = (bf16x8){lo[ks][0], lo[ks][1], lo[ks][2], lo[ks][3], hh[ks][0], hh[ks][1], hh[ks][2], hh[ks][3]};
                    if (d0 == 0) o0 = __builtin_amdgcn_mfma_f32_32x32x16_bf16(pa[ks], vf, o0, 0, 0, 0); else o1 = __builtin_amdgcn_mfma_f32_32x32x16_bf16(pa[ks], vf, o1, 0, 0, 0);
                }
            }
        }
        { const bool done = (t > 0) && (nb[t * 64 - 1] + qkb <= mrun); const int fl = __all(done) ? 1 : 0; if (lane == 0) MM[(it & 1) * 8 + wid] = fl; }
    }
    lrun += __shfl_xor(lrun, 32);
    if (hi == 0) al[r32] = 1.f / lrun;
    asm volatile("s_waitcnt lgkmcnt(0)" ::: "memory");
    bf16* Ow = OMIX + (rowbase + q0 + wid * 32) * DM + 512 + h * 64;
#pragma unroll
    for (int r = 0; r < 16; ++r) { const int orow = crow(r, hi); const float il = al[orow];
        Ow[(size_t)orow * DM + r32] = (bf16)f2bf(o0[r] * il); Ow[(size_t)orow * DM + 32 + r32] = (bf16)f2bf(o1[r] * il); }
    __syncthreads();
}
__device__ __forceinline__ void phase(LAS unsigned char* lds, const bf16* PE, const float* F, const float* KMAX, bf16* OMIX) {
    const int bx = blockIdx.x, G = gridDim.x; const int vcu = (G % 8 == 0) ? (bx % 8) * (G / 8) + bx / 8 : bx;
    for (int v = vcu; v < 256; v += G) {
        const int bh = v >> 2, sub = v & 3;
#pragma unroll 1
        for (int i = 0; i < 4; ++i) { const int qb = (i == 0) ? sub : (i == 1) ? 7 - sub : (i == 2) ? 8 + sub : 15 - sub; attn_unit(bh >> 3, bh & 7, qb, PE, F, KMAX, OMIX, lds); }
    }
}
__device__ __forceinline__ void scan_phase(LAS unsigned char* lds, const float* TE, const float* bfv, const bf16* PE, float* F, float* KMAX) {
    const int lane = threadIdx.x & 63, wid = threadIdx.x >> 6;
    LAS float* red = (LAS float*)lds;
    for (int bh = blockIdx.x; bh < 64; bh += gridDim.x) {
        const int b = bh >> 3, h = bh & 7;
        {
            const float bb = bfv[h]; const int tid = threadIdx.x;
            float v[8];
#pragma unroll
            for (int i = 0; i < 8; ++i) v[i] = TE[((size_t)b * SEQ + tid * 8 + i) * 32 + 16 + h];
            float run = 0.f;
#pragma unroll
            for (int i = 0; i < 8; ++i) { run += log_sigmoid(v[i] + bb); v[i] = run; }
            float inc = run;
#pragma unroll
            for (int o = 1; o < 64; o <<= 1) { const float y = __shfl_up(inc, o); if (lane >= o) inc += y; }
            if (lane == 63) red[16 + wid] = inc;
            __syncthreads();
            float pre = inc - run;
            for (int w = 0; w < wid; ++w) pre += red[16 + w];
            f32x4* fo = (f32x4*)(F + (size_t)bh * SEQ + tid * 8);
            fo[0] = (f32x4){v[0] + pre, v[1] + pre, v[2] + pre, v[3] + pre}; fo[1] = (f32x4){v[4] + pre, v[5] + pre, v[6] + pre, v[7] + pre};
        }
        float mx = 0.f;
        for (int r = 0; r < 8; ++r) { const bf16* kr = PE + ((size_t)b * SEQ + wid * 512 + r * 64 + lane) * PITCH + 2048 + h * 64; float s2 = 0.f;
#pragma unroll
            for (int c = 0; c < 8; ++c) { const v4u kv = *(const v4u*)(kr + c * 8);
#pragma unroll
                for (int e = 0; e < 4; ++e) { const float k0 = __builtin_bit_cast(float, kv[e] << 16), k1 = __builtin_bit_cast(float, kv[e] & 0xffff0000u); s2 += k0 * k0 + k1 * k1; } }
            mx = fmaxf(mx, s2); }
        mx = wave_max(mx);
        if (lane == 0) red[wid] = mx;
        __syncthreads();
        if (threadIdx.x == 0) KMAX[bh] = fmaxf(fmaxf(fmaxf(red[0], red[1]), fmaxf(red[2], red[3])), fmaxf(fmaxf(red[4], red[5]), fmaxf(red[6], red[7])));
        __syncthreads();
    }
}
}
namespace gla {
typedef short bf16x8 __attribute__((ext_vector_type(8)));
typedef short s16x4 __attribute__((ext_vector_type(4)));
typedef float f32x16 __attribute__((ext_vector_type(16)));
typedef float f32x2 __attribute__((ext_vector_type(2)));
constexpr int L_GS = 0, L_SEG = 16384, L_KD = 18432, L_QD = 26624, L_V = 34816, L_S = 51200, L_SSQ = 67584, L_WG = 68608, L_GATE = 73216, GPITCH = 272, LDS_BYTES = L_GATE + 64 * GPITCH;
__device__ __forceinline__ int crow(int r, int hi) { return (r & 3) + 8 * (r >> 2) + 4 * hi; }
__device__ __forceinline__ s16x4 trq(unsigned addr) { s16x4 r; asm volatile("ds_read_b64_tr_b16 %0, %1" : "=&v"(r) : "v"(addr) : "memory"); return r; }
#define GLA_LDS_WAIT() do { asm volatile("s_waitcnt lgkmcnt(0)" ::: "memory"); __builtin_amdgcn_sched_barrier(0); } while (0)
__device__ __forceinline__ bf16x8 cat(s16x4 a, s16x4 b) { return (bf16x8){a[0], a[1], a[2], a[3], b[0], b[1], b[2], b[3]}; }
__device__ __forceinline__ unsigned cvtpk(float lo, float hi) { return pg8::cvt_pk_bf16(lo, hi); }
__device__ __forceinline__ float bfe(const v4u& v, int e) { return __builtin_bit_cast(float, (e & 1) ? (v[e >> 1] & 0xffff0000u) : (v[e >> 1] << 16)); }
__device__ __forceinline__ int tr_off(int row, int col) { return ((col >> 5) * 4 + (row >> 4)) * 1024 + (row & 15) * 64 + ((col >> 3) & 3) * 16; }

struct In1 { f32x4 te[4]; v4u k, v0, v1; };
struct In3 { f32x4 te[4]; v4u q, k, v0, v1, s0, s1, g0, g1; };
__device__ __forceinline__ void chunk_ids(int ch, int& b, int& h, size_t& m0) { const int bh = ch >> 6, n = ch & 63; b = bh >> 2; h = bh & 3; m0 = (size_t)b * SEQ + n * 64; }
__device__ __forceinline__ void load_in1(In1& I, const bf16* PE, const float* TE, int ch) {
    int b, h; size_t m0; chunk_ids(ch, b, h, m0);
    const int t = threadIdx.x >> 3, dg = threadIdx.x & 7; const f32x4* te = (const f32x4*)(TE + (m0 + t) * 32); const bf16* pe = PE + (m0 + t) * NE_BF;
#pragma unroll
    for (int j = 0; j < 4; ++j) I.te[j] = te[j];
    I.k = *(const v4u*)(pe + 256 + h * 64 + dg * 8); I.v0 = *(const v4u*)(pe + 512 + h * 128 + dg * 16); I.v1 = *(const v4u*)(pe + 512 + h * 128 + dg * 16 + 8);
}
__device__ __forceinline__ void load_in3(In3& I, const bf16* PE, const float* TE, const bf16* SP, int ch) {
    int b, h; size_t m0; chunk_ids(ch, b, h, m0);
    const int t = threadIdx.x >> 3, dg = threadIdx.x & 7; const f32x4* te = (const f32x4*)(TE + (m0 + t) * 32); const bf16* pe = PE + (m0 + t) * NE_BF;
#pragma unroll
    for (int j = 0; j < 4; ++j) I.te[j] = te[j];
    I.q = *(const v4u*)(pe + h * 64 + dg * 8); I.k = *(const v4u*)(pe + 256 + h * 64 + dg * 8);
    I.v0 = *(const v4u*)(pe + 512 + h * 128 + dg * 16); I.v1 = *(const v4u*)(pe + 512 + h * 128 + dg * 16 + 8);
    I.g0 = *(const v4u*)(pe + 1024 + h * 128 + dg * 16); I.g1 = *(const v4u*)(pe + 1024 + h * 128 + dg * 16 + 8);
    const bf16* sp = SP + ((size_t)ch * 64 + t) * 128 + dg * 16; I.s0 = *(const v4u*)sp; I.s1 = *(const v4u*)(sp + 8);
}
__device__ __forceinline__ void load_wg(LAS unsigned char* lds, const float* Wg, const float* bg, int h) {
    LAS float* W = (LAS float*)(lds + L_WG);
    for (int i = threadIdx.x; i < 17 * 64; i += 512) { const int r = i >> 6, d = i & 63; W[i] = r < 16 ? Wg[r * 256 + h * 64 + d] : bg[h * 64 + d]; }
    __syncthreads();
}
__device__ __forceinline__ void gates(LAS unsigned char* lds, const f32x4 (&te)[4]) {
    const int tid = threadIdx.x;
    LAS float* GS = (LAS float*)(lds + L_GS); LAS float* SEG = (LAS float*)(lds + L_SEG); const LAS float* W = (const LAS float*)(lds + L_WG);
    { const int t = tid >> 3, dg = tid & 7;
        const LAS f32x4* wb = (const LAS f32x4*)(W + 16 * 64 + dg * 8);
        f32x4 x0 = wb[0], x1 = wb[1];
#pragma unroll
        for (int r = 0; r < 16; ++r) { const float tv = te[r >> 2][r & 3]; const LAS f32x4* wr = (const LAS f32x4*)(W + r * 64 + dg * 8); x0 += wr[0] * tv; x1 += wr[1] * tv; }
        f32x4 g0, g1;
#pragma unroll
        for (int e = 0; e < 4; ++e) { g0[e] = log_sigmoid(x0[e]) * (1.f / 16.f); g1[e] = log_sigmoid(x1[e]) * (1.f / 16.f); }
        *(LAS f32x4*)(GS + t * 64 + dg * 8) = g0; *(LAS f32x4*)(GS + t * 64 + dg * 8 + 4) = g1; }
    __syncthreads();
    { const int d = tid & 63, seg = tid >> 6; float run = 0.f;
#pragma unroll
        for (int i = 0; i < 8; ++i) { run += GS[(seg * 8 + i) * 64 + d]; GS[(seg * 8 + i) * 64 + d] = run; }
        SEG[seg * 64 + d] = run;
        __syncthreads();
        float pre = 0.f;
        for (int s = 0; s < seg; ++s) pre += SEG[s * 64 + d];
#pragma unroll
        for (int i = 0; i < 8; ++i) GS[(seg * 8 + i) * 64 + d] += pre; }
    __syncthreads();
}
__device__ __forceinline__ void g1_phase(LAS unsigned char* lds, const bf16* PE, const float* TE, const float* Wg, const float* bg, float* U, float* DEC) {
    const int tid = threadIdx.x, lane = tid & 63, r32 = lane & 31, hi = lane >> 5; const int wid = __builtin_amdgcn_readfirstlane(tid >> 6);
    LAS float* GS = (LAS float*)(lds + L_GS); LAS float* SEG = (LAS float*)(lds + L_SEG);
    if ((int)blockIdx.x >= 2048) return;
    int hcur = -1;
    In1 I; load_in1(I, PE, TE, blockIdx.x);
    for (int ch = blockIdx.x; ch < 2048; ch += gridDim.x) {
        { const int hh = (ch >> 6) & 3; if (hh != hcur) { __syncthreads(); load_wg(lds, Wg, bg, hh); hcur = hh; } }
        gates(lds, I.te);
        { const int t = tid >> 3, dg = tid & 7;
            float ke[8];
#pragma unroll
            for (int e = 0; e < 8; ++e) { const int d = dg * 8 + e; float gl = 0.f;
#pragma unroll
                for (int s = 0; s < 8; ++s) gl += SEG[s * 64 + d];
                ke[e] = bfe(I.k, e) * expf(gl - GS[t * 64 + d]); }
            v4u o; o.x = cvtpk(ke[0], ke[1]); o.y = cvtpk(ke[2], ke[3]); o.z = cvtpk(ke[4], ke[5]); o.w = cvtpk(ke[6], ke[7]);
            *(LAS v4u*)(lds + L_KD + tr_off(t, dg * 8)) = o;
            *(LAS v4u*)(lds + L_V + tr_off(t, dg * 16)) = I.v0; *(LAS v4u*)(lds + L_V + tr_off(t, dg * 16 + 8)) = I.v1; }
        if (tid < 64) { float gl = 0.f;
#pragma unroll
            for (int s = 0; s < 8; ++s) gl += SEG[s * 64 + tid];
            DEC[(size_t)ch * 64 + tid] = expf(gl); }
        __syncthreads();
        if (ch + (int)gridDim.x < 2048) load_in1(I, PE, TE, ch + gridDim.x);
        { const int mt = wid & 1, nt = wid >> 1; const int q = (lane & 15) >> 2, p = lane & 3, blk = (lane >> 4) & 1;
            const unsigned lb = (unsigned)(size_t)lds, ro = (8 * hi + q) * 64 + blk * 32 + p * 8;
            s16x4 fa[4][2], fb[4][2];
#pragma unroll
            for (int ks = 0; ks < 4; ++ks) { const unsigned aa = lb + L_KD + (mt * 4 + ks) * 1024 + ro, ba = lb + L_V + (nt * 4 + ks) * 1024 + ro;
                fa[ks][0] = trq(aa); fa[ks][1] = trq(aa + 256); fb[ks][0] = trq(ba); fb[ks][1] = trq(ba + 256); }
            GLA_LDS_WAIT();
            f32x16 acc;
#pragma unroll
            for (int r = 0; r < 16; ++r) acc[r] = 0.f;
#pragma unroll
            for (int ks = 0; ks < 4; ++ks) acc = __builtin_amdgcn_mfma_f32_32x32x16_bf16(cat(fa[ks][0], fa[ks][1]), cat(fb[ks][0], fb[ks][1]), acc, 0, 0, 0);
            float* Uo = U + (size_t)ch * 8192 + nt * 32 + r32;
#pragma unroll
            for (int r = 0; r < 16; ++r) Uo[(size_t)(mt * 32 + crow(r, hi)) * 128] = acc[r]; }
    }
}
__device__ __forceinline__ void g2_phase(const float* U, const float* DEC, bf16* SP) {
    for (int gid = blockIdx.x * 512 + threadIdx.x; gid < 131072; gid += gridDim.x * 512) {
        const int bh = gid >> 12, d = (gid >> 6) & 63, v2 = gid & 63;
        f32x2 S = {0.f, 0.f};
#pragma unroll 8
        for (int n = 0; n < 64; ++n) { const size_t ch = (size_t)bh * 64 + n; const size_t off = (ch * 64 + d) * 128 + 2 * v2;
            const f32x2 u = *(const f32x2*)(U + off); const float dc = DEC[ch * 64 + d];
            *(unsigned*)(SP + off) = pk2(S.x, S.y);
            S = S * dc + u; }
    }
}
__device__ __forceinline__ void g3_phase(LAS unsigned char* lds, const bf16* PE, const float* TE, const float* Wg, const float* bg, const bf16* SP, const float* gn, bf16* OMIX) {
    const int tid = threadIdx.x, lane = tid & 63, r32 = lane & 31, hi = lane >> 5; const int wid = __builtin_amdgcn_readfirstlane(tid >> 6);
    LAS float* GS = (LAS float*)(lds + L_GS); LAS float* SSQ = (LAS float*)(lds + L_SSQ);
    if ((int)blockIdx.x >= 2048) return;
    int hcur = -1;
    In3 I; load_in3(I, PE, TE, SP, blockIdx.x);
    for (int ch = blockIdx.x; ch < 2048; ch += gridDim.x) {
        int b, h; size_t m0; chunk_ids(ch, b, h, m0);
        if (h != hcur) { __syncthreads(); load_wg(lds, Wg, bg, h); hcur = h; }
        gates(lds, I.te);
        { const int t = tid >> 3, dg = tid & 7;
            const f32x4 ga = *(const LAS f32x4*)(GS + t * 64 + dg * 8), gb = *(const LAS f32x4*)(GS + t * 64 + dg * 8 + 4);
            float qd[8], kd[8];
#pragma unroll
            for (int e = 0; e < 8; ++e) { const float g = e < 4 ? ga[e & 3] : gb[e & 3]; qd[e] = bfe(I.q, e) * 0.125f * expf(g); kd[e] = bfe(I.k, e) * expf(-g); }
            v4u o; o.x = cvtpk(qd[0], qd[1]); o.y = cvtpk(qd[2], qd[3]); o.z = cvtpk(qd[4], qd[5]); o.w = cvtpk(qd[6], qd[7]);
            *(LAS v4u*)(lds + L_QD + dg * 1024 + t * 16) = o;
            o.x = cvtpk(kd[0], kd[1]); o.y = cvtpk(kd[2], kd[3]); o.z = cvtpk(kd[4], kd[5]); o.w = cvtpk(kd[6], kd[7]);
            *(LAS v4u*)(lds + L_KD + dg * 1024 + t * 16) = o;
            *(LAS v4u*)(lds + L_V + tr_off(t, dg * 16)) = I.v0; *(LAS v4u*)(lds + L_V + tr_off(t, dg * 16 + 8)) = I.v1;
            *(LAS v4u*)(lds + L_S + tr_off(t, dg * 16)) = I.s0; *(LAS v4u*)(lds + L_S + tr_off(t, dg * 16 + 8)) = I.s1;
            *(LAS v4u*)(lds + L_GATE + t * GPITCH + dg * 32) = I.g0; *(LAS v4u*)(lds + L_GATE + t * GPITCH + dg * 32 + 16) = I.g1; }
        __syncthreads();
        if (ch + (int)gridDim.x < 2048) load_in3(I, PE, TE, SP, ch + gridDim.x);
        const int it = wid & 1, nt = wid >> 1; const int q = (lane & 15) >> 2, p = lane & 3, blk = (lane >> 4) & 1;
        const unsigned lb = (unsigned)(size_t)lds;
        f32x16 acc;
#pragma unroll
        for (int r = 0; r < 16; ++r) acc[r] = 0.f;
        { bf16x8 af[4]; s16x4 sb[4][2];
#pragma unroll
            for (int ks = 0; ks < 4; ++ks) { af[ks] = *(const LAS bf16x8*)(lds + L_QD + (2 * ks + hi) * 1024 + (32 * it + r32) * 16);
                const unsigned ba = lb + L_S + (nt * 4 + ks) * 1024 + (8 * hi + q) * 64 + blk * 32 + p * 8; sb[ks][0] = trq(ba); sb[ks][1] = trq(ba + 256); }
            GLA_LDS_WAIT();
#pragma unroll
            for (int ks = 0; ks < 4; ++ks) acc = __builtin_amdgcn_mfma_f32_32x32x16_bf16(af[ks], cat(sb[ks][0], sb[ks][1]), acc, 0, 0, 0); }
        for (int jt = 0; jt <= it; ++jt) {
            bf16x8 kf[4], qf[4]; s16x4 vv[2][2];
#pragma unroll
            for (int ks = 0; ks < 4; ++ks) { kf[ks] = *(const LAS bf16x8*)(lds + L_KD + (2 * ks + hi) * 1024 + (32 * jt + r32) * 16); qf[ks] = *(const LAS bf16x8*)(lds + L_QD + (2 * ks + hi) * 1024 + (32 * it + r32) * 16); }
#pragma unroll
            for (int s = 0; s < 2; ++s) { const unsigned va = lb + L_V + (nt * 4 + 2 * jt + s) * 1024 + (4 * hi + q) * 64 + blk * 32 + p * 8; vv[s][0] = trq(va); vv[s][1] = trq(va + 512); }
            GLA_LDS_WAIT();
            f32x16 X;
#pragma unroll
            for (int r = 0; r < 16; ++r) X[r] = 0.f;
#pragma unroll
            for (int ks = 0; ks < 4; ++ks) X = __builtin_amdgcn_mfma_f32_32x32x16_bf16(kf[ks], qf[ks], X, 0, 0, 0);
            if (jt == it) {
#pragma unroll
                for (int r = 0; r < 16; ++r) if (crow(r, hi) > r32) X[r] = 0.f;
            }
#pragma unroll
            for (int s = 0; s < 2; ++s) {
                v4u w; w.x = cvtpk(X[8 * s + 0], X[8 * s + 1]); w.y = cvtpk(X[8 * s + 2], X[8 * s + 3]); w.z = cvtpk(X[8 * s + 4], X[8 * s + 5]); w.w = cvtpk(X[8 * s + 6], X[8 * s + 7]);
                acc = __builtin_amdgcn_mfma_f32_32x32x16_bf16(__builtin_bit_cast(bf16x8, w), cat(vv[s][0], vv[s][1]), acc, 0, 0, 0);
            }
        }
#pragma unroll
        for (int r = 0; r < 16; ++r) { float s = acc[r] * acc[r];
            s += __shfl_xor(s, 1); s += __shfl_xor(s, 2); s += __shfl_xor(s, 4); s += __shfl_xor(s, 8); s += __shfl_xor(s, 16);
            if (r32 == 0) SSQ[(32 * it + crow(r, hi)) * 4 + nt] = s; }
        __syncthreads();
        { const int v = nt * 32 + r32; const float gnv = gn[v];
#pragma unroll
            for (int r = 0; r < 16; ++r) { const int i = 32 * it + crow(r, hi); const f32x4 sq = *(const LAS f32x4*)(SSQ + i * 4);
                const float rstd = rsqrtf(((sq.x + sq.y) + (sq.z + sq.w)) * (1.f / 128.f) + EPS);
                LAS unsigned short* gp = (LAS unsigned short*)(lds + L_GATE + i * GPITCH) + v;
                const float g = bf2f(*gp);
                *gp = (unsigned short)f2bf(acc[r] * rstd * gnv * (g * __builtin_amdgcn_rcpf(1.f + __builtin_amdgcn_exp2f(-1.4426950408889634f * g)))); } }
        __syncthreads();
        { const int t = tid >> 3, dg = tid & 7; const v4u o0 = *(const LAS v4u*)(lds + L_GATE + t * GPITCH + dg * 32), o1 = *(const LAS v4u*)(lds + L_GATE + t * GPITCH + dg * 32 + 16);
            bf16* op = OMIX + (m0 + t) * DM + h * 128 + dg * 16; *(v4u*)op = o0; *(v4u*)(op + 8) = o1; }
    }
}
}
namespace dsa {
typedef short bf16x8 __attribute__((ext_vector_type(8)));
typedef short s16x4 __attribute__((ext_vector_type(4)));
constexpr float L2E = 1.4426950408889634f;
constexpr int PIECE = 1056, CHUNK_BYTES = 16 * PIECE;
constexpr int NBIN = 256;
constexpr int W_ROW = 8192, W_CAND = 16384, W_HIST = CHUNK_BYTES, W_LIST = W_HIST + 1056, WAVE_LDS = W_LIST + 2048;
constexpr int L_WAVE = 0, L_T5 = 8 * WAVE_LDS, L_LUT = L_T5 + 2048, L_MM = L_LUT + 128, LDS_BYTES = L_MM + 1024;
constexpr size_t SCR_QL = 0, SCR_OL = 262144, SCR_BYTES = 524288;
__device__ __forceinline__ bf16x8 cat(s16x4 a, s16x4 b) { return (bf16x8){a[0], a[1], a[2], a[3], b[0], b[1], b[2], b[3]}; }
__device__ __forceinline__ int wave_isum(int v) {
#pragma unroll
    for (int o = 1; o < 64; o <<= 1) v += __shfl_xor(v, o);
    return v;
}
__device__ __forceinline__ int mbcnt64(unsigned long long m) { return __builtin_amdgcn_mbcnt_hi((unsigned)(m >> 32), __builtin_amdgcn_mbcnt_lo((unsigned)m, 0u)); }

__device__ __forceinline__ int bin_of(float x, float lo, float scale) { int b = (int)((x - lo) * scale); b = b < 0 ? 0 : b; return b > NBIN - 1 ? NBIN - 1 : b; }
typedef _Float16 f16x4 __attribute__((ext_vector_type(4)));
__device__ __forceinline__ f32x4 ldrow(const LAS unsigned char* rowp, int J, int lane, int t) {
    const int s0 = 256 * J + 4 * lane;
    const f16x4 hv = *(const LAS f16x4*)(rowp + 2 * s0);
    f32x4 x = __builtin_convertvector(hv, f32x4);
#pragma unroll
    for (int e = 0; e < 4; ++e) x[e] = s0 + e <= t ? x[e] : -INFINITY;
    return x;
}
__device__ __forceinline__ int enc_key(int s, int t, const LAS unsigned char* lut) { const int d = t - s; return s | ((d < 128 ? (int)lut[d] : 31) << 16); }
__device__ __forceinline__ int select_row(const LAS unsigned char* rowp, int t, float lo, float hi, LAS int* list, LAS unsigned* hist, LAS float* candv, LAS int* candi, const LAS unsigned char* lut, int lane) {
    const int n = t + 1;
    if (n <= 256) {
#pragma unroll
        for (int j = 0; j < 4; ++j) { const int s = lane + 64 * j; list[s] = s <= t ? enc_key(s, t, lut) : -1; }
        return n;
    }
    const int nJ = (t >> 8) + 1;
    const float scale = hi > lo ? (float)(NBIN - 1) / (hi - lo) : 0.f;
#pragma unroll
    for (int j = 0; j < NBIN / 64; ++j) hist[lane + 64 * j] = 0u;
#pragma unroll 2
    for (int J = 0; J < nJ; ++J) { const f32x4 x = ldrow(rowp, J, lane, t);
#pragma unroll
        for (int e = 0; e < 4; ++e) if (x[e] != -INFINITY) __hip_atomic_fetch_add(hist + bin_of(x[e], lo, scale), 1u, __ATOMIC_RELAXED, __HIP_MEMORY_SCOPE_WORKGROUP); }
    const v4u h4 = *(const LAS v4u*)(hist + 4 * lane);
    const int cl = (int)(h4.x + h4.y + h4.z + h4.w);
    int suf = cl;
#pragma unroll
    for (int o = 1; o < 64; o <<= 1) { const int y = __shfl_down(suf, o); if (lane + o < 64) suf += y; }
    const unsigned long long bal = __ballot(suf >= 256);
    const int Lt = 63 - __builtin_clzll(bal);
    int Tb, above;
    { int cum = suf - cl;
        if (cum + (int)h4.w >= 256) { Tb = 4 * lane + 3; above = cum; }
        else { cum += (int)h4.w; if (cum + (int)h4.z >= 256) { Tb = 4 * lane + 2; above = cum; }
        else { cum += (int)h4.z; if (cum + (int)h4.y >= 256) { Tb = 4 * lane + 1; above = cum; }
        else { cum += (int)h4.y; Tb = 4 * lane; above = cum; } } } }
    Tb = __shfl(Tb, Lt); above = __shfl(above, Lt);
    const int r = 256 - above;
    int base = 0, ccount = 0;
#pragma unroll 2
    for (int J = 0; J < nJ; ++J) { const f32x4 x = ldrow(rowp, J, lane, t);
#pragma unroll
        for (int e = 0; e < 4; ++e) { const int bb = x[e] != -INFINITY ? bin_of(x[e], lo, scale) : -1; const int s = 256 * J + 4 * lane + e;
            const unsigned long long gm = __ballot(bb > Tb);
            if (gm) { if (bb > Tb) list[base + mbcnt64(gm)] = enc_key(s, t, lut); base += __builtin_popcountll(gm); }
            const unsigned long long cm = __ballot(bb == Tb);
            if (cm) { const int p = ccount + mbcnt64(cm); if (bb == Tb && p < 64) { candv[p] = x[e]; candi[p] = s; } ccount += __builtin_popcountll(cm); } } }
    if (ccount <= 64) {
        const float xv = lane < ccount ? candv[lane] : -INFINITY; const int xi = lane < ccount ? candi[lane] : 0x7fffffff;
        int rank = 0;
#pragma unroll 4
        for (int j = 0; j < ccount; ++j) { const float yv = candv[j]; const int yi = candi[j]; rank += (yv > xv || (yv == xv && yi < xi)) ? 1 : 0; }
        const bool sel = lane < ccount && rank < r;
        const unsigned long long sm = __ballot(sel);
        if (sel) list[above + mbcnt64(sm)] = enc_key(xi, t, lut);
        return 256;
    }
    float tau; int cgt;
    { unsigned key = 0u;
        for (int bit = 31; bit >= 0; --bit) {
            const unsigned cnd = key | (1u << bit); int c = 0;
            for (int J = 0; J < nJ; ++J) { const f32x4 x = ldrow(rowp, J, lane, t);
#pragma unroll
                for (int e = 0; e < 4; ++e) if (x[e] != -INFINITY) c += (bin_of(x[e], lo, scale) == Tb && ord_key(x[e]) >= cnd) ? 1 : 0; }
            if (wave_isum(c) >= r) key = cnd;
        }
        const unsigned ub = (key & 0x80000000u) ? (key & 0x7fffffffu) : ~key;
        tau = __builtin_bit_cast(float, ub);
        int c = 0;
        for (int J = 0; J < nJ; ++J) { const f32x4 x = ldrow(rowp, J, lane, t);
#pragma unroll
            for (int e = 0; e < 4; ++e) if (x[e] != -INFINITY) c += (bin_of(x[e], lo, scale) == Tb && x[e] > tau) ? 1 : 0; }
        cgt = wave_isum(c); }
    const int req = 256 - (above + cgt);
    base = 0; int taken = 0;
    for (int J = 0; J < nJ; ++J) {
        const f32x4 x = ldrow(rowp, J, lane, t);
        unsigned long long em[4]; int ebef = 0, ecnt = 0;
#pragma unroll
        for (int e = 0; e < 4; ++e) { em[e] = __ballot(x[e] == tau); ebef += mbcnt64(em[e]); ecnt += __builtin_popcountll(em[e]); }
        bool sel[4]; int own = 0;
#pragma unroll
        for (int e = 0; e < 4; ++e) { const bool eq = x[e] == tau; sel[e] = x[e] > tau || (eq && taken + ebef + own < req); own += eq ? 1 : 0; }
        unsigned long long sm[4]; int sbef = 0, scnt = 0;
#pragma unroll
        for (int e = 0; e < 4; ++e) { sm[e] = __ballot(sel[e]); sbef += mbcnt64(sm[e]); scnt += __builtin_popcountll(sm[e]); }
        int pos = base + sbef;
#pragma unroll
        for (int e = 0; e < 4; ++e) if (sel[e]) { list[pos] = enc_key(256 * J + 4 * lane + e, t, lut); ++pos; }
        base += scnt; taken += ecnt;
    }
    return 256;
}

__device__ __forceinline__ void phase(LAS unsigned char* lds, const bf16* PO, const float* TO, const unsigned char* C8, const bf16* WUKT, const unsigned char* WUVT8, const float* t5, unsigned char* scratch, bf16* OMIX) {
    const int tid = threadIdx.x, lane = tid & 63, l15_ = lane & 15, g_ = lane >> 4; const int wid = __builtin_amdgcn_readfirstlane(tid >> 6);
    const int bx = blockIdx.x, G = gridDim.x; const int vcu = (G % 8 == 0) ? (bx % 8) * (G / 8) + bx / 8 : bx;
    LAS float* t5l = (LAS float*)(lds + L_T5); LAS unsigned char* lut = lds + L_LUT;
    LAS unsigned char* wl = lds + L_WAVE + wid * WAVE_LDS;
    LAS unsigned* hist = (LAS unsigned*)(wl + W_HIST); LAS int* list0 = (LAS int*)(wl + W_LIST); LAS float* cand = (LAS float*)(wl + W_CAND);
    unsigned char* scr = scratch + (size_t)bx * SCR_BYTES;
    unsigned char* QL = scr + SCR_QL; unsigned char* OL = scr + SCR_OL;
    t5l[tid] = t5[tid] * L2E;
    if (tid < 128) lut[tid] = (unsigned char)t5_bucket(tid);
    __syncthreads();
    for (int v = vcu; v < 256; v += G) {
        const int b = v >> 5, jj = v & 31;
#pragma unroll 1
        for (int tg = 0; tg < 2; ++tg) {
#define DSA_TQ(s) (64 * (2 * tg + ((s) >> 1)) + (((s) & 1) ? 63 - jj : jj))
            const size_t mb0 = (size_t)b * SEQ;
#pragma unroll 1
            for (int hq = 0; hq < 2; ++hq) { const int hh = 2 * wid + hq;
                int l15 = l15_, g = g_; asm volatile("" : "+v"(l15), "+v"(g));
                bf16x8 bq[4][2];
#pragma unroll
                for (int sub = 0; sub < 4; ++sub)
#pragma unroll
                    for (int ks = 0; ks < 2; ++ks) bq[sub][ks] = *(const bf16x8*)(PO + (mb0 + 16 * DSA_TQ(sub) + l15) * NO_IN + hh * 64 + 32 * ks + 8 * g);
                const bf16* wp0 = WUKT + ((size_t)(hh * 256 + l15)) * 64 + 8 * g;
#pragma unroll 1
                for (int lh = 0; lh < 2; ++lh) {
                    bf16x8 wa[8][2];
#pragma unroll
                    for (int k = 0; k < 8; ++k) { const bf16* wp = wp0 + (size_t)(16 * (8 * lh + k)) * 64; wa[k][0] = *(const bf16x8*)wp; wa[k][1] = *(const bf16x8*)(wp + 32); }
#pragma unroll
                    for (int sub = 0; sub < 4; ++sub)
#pragma unroll
                        for (int k = 0; k < 8; ++k) { const int lt = 8 * lh + k;
                            f32x4 acc = {0.f, 0.f, 0.f, 0.f};
                            acc = __builtin_amdgcn_mfma_f32_16x16x32_bf16(wa[k][0], bq[sub][0], acc, 0, 0, 0);
                            acc = __builtin_amdgcn_mfma_f32_16x16x32_bf16(wa[k][1], bq[sub][1], acc, 0, 0, 0);
                            { int p8 = __builtin_amdgcn_cvt_pk_fp8_f32(acc[0], acc[1], 0, false); p8 = __builtin_amdgcn_cvt_pk_fp8_f32(acc[2], acc[3], p8, true);
                                *(int*)(QL + sub * 65536 + ((size_t)((hh * 16 + lt) * 16 + l15)) * 16 + 4 * g) = p8; } }
                } }
#pragma unroll 1
            for (int sub = 0; sub < 4; ++sub) {
            const int tq = DSA_TQ(sub); const int t0 = tq * 16; const size_t m0 = mb0 + t0; const unsigned char* QLt = QL + sub * 65536; unsigned char* OLt = OL + sub * 65536;
            {
                int l15 = l15_, g = g_; asm volatile("" : "+v"(l15), "+v"(g));
                bf16x8 aq[8][2]; float wq[4][8];
#pragma unroll
                for (int hh = 0; hh < 8; ++hh)
#pragma unroll
                    for (int ks = 0; ks < 2; ++ks) aq[hh][ks] = *(const bf16x8*)(PO + (m0 + l15) * NO_IN + 1280 + hh * 64 + 32 * ks + 8 * g);
#pragma unroll
                for (int i = 0; i < 4; ++i)
#pragma unroll
                    for (int hh = 0; hh < 8; ++hh) wq[i][hh] = TO[(m0 + 4 * g + i) * 32 + hh] * (0.35355339059327373f * 0.125f);
                const bf16* kp0 = PO + (mb0 + l15) * NO_IN + 1800 + 8 * g;
                bf16x8 nk0 = (bf16x8){0, 0, 0, 0, 0, 0, 0, 0}, nk1 = nk0;
                if (wid <= tq) { const bf16* kp = kp0 + (size_t)(16 * wid) * NO_IN; nk0 = *(const bf16x8*)kp; nk1 = *(const bf16x8*)(kp + 32); }
                float rlo[4] = {INFINITY, INFINITY, INFINITY, INFINITY}, rhi[4] = {-INFINITY, -INFINITY, -INFINITY, -INFINITY};
                for (int kt = wid; kt <= tq; kt += 8) {
                    const bf16x8 bk0 = nk0, bk1 = nk1;
                    if (kt + 8 <= tq) { const bf16* kp = kp0 + (size_t)(16 * (kt + 8)) * NO_IN; nk0 = *(const bf16x8*)kp; nk1 = *(const bf16x8*)(kp + 32); }
                    float sc[4] = {0.f, 0.f, 0.f, 0.f};
#pragma unroll
                    for (int hh = 0; hh < 8; ++hh) {
                        f32x4 acc = {0.f, 0.f, 0.f, 0.f};
                        acc = __builtin_amdgcn_mfma_f32_16x16x32_bf16(aq[hh][0], bk0, acc, 0, 0, 0);
                        acc = __builtin_amdgcn_mfma_f32_16x16x32_bf16(aq[hh][1], bk1, acc, 0, 0, 0);
#pragma unroll
                        for (int i = 0; i < 4; ++i) sc[i] += wq[i][hh] * fmaxf(acc[i], 0.f);
                    }
#pragma unroll
                    for (int i = 0; i < 4; ++i) { const int q = 4 * g + i; const _Float16 hs = (_Float16)sc[i]; const float fs = (float)hs; rlo[i] = fminf(rlo[i], fs); rhi[i] = fmaxf(rhi[i], fs);
                        *(LAS _Float16*)(lds + L_WAVE + (q >> 1) * WAVE_LDS + (q & 1) * W_ROW + (16 * kt + l15) * 2) = hs; }
                }
#pragma unroll
                for (int i = 0; i < 4; ++i) {
#pragma unroll
                    for (int o = 1; o < 16; o <<= 1) { rlo[i] = fminf(rlo[i], __shfl_xor(rlo[i], o)); rhi[i] = fmaxf(rhi[i], __shfl_xor(rhi[i], o)); }
                    if (l15 == 0) { LAS float* mm = (LAS float*)(lds + L_MM) + (wid * 16 + 4 * g + i) * 2; mm[0] = rlo[i]; mm[1] = rhi[i]; } }
            }
            __syncthreads();
            int nsel0, nsel1;
            { int lnv = lane; asm volatile("" : "+v"(lnv));
                const LAS float* mm = (const LAS float*)(lds + L_MM);
                float lo0 = INFINITY, hi0 = -INFINITY, lo1 = INFINITY, hi1 = -INFINITY;
#pragma unroll
                for (int w = 0; w < 8; ++w) { const f32x4 m4 = *(const LAS f32x4*)(mm + (w * 16 + 2 * wid) * 2); lo0 = fminf(lo0, m4.x); hi0 = fmaxf(hi0, m4.y); lo1 = fminf(lo1, m4.z); hi1 = fmaxf(hi1, m4.w); }
                nsel0 = select_row(wl, t0 + 2 * wid, lo0, hi0, list0, hist, cand, (LAS int*)(cand + 64), lut, lnv);
                nsel1 = select_row(wl + W_ROW, t0 + 2 * wid + 1, lo1, hi1, list0 + 256, hist, cand, (LAS int*)(cand + 64), lut, lnv); }
#pragma unroll 1
            for (int rq = 0; rq < 2; ++rq) {
                int l15 = l15_, g = g_, lnv = lane; asm volatile("" : "+v"(l15), "+v"(g), "+v"(lnv));
                const int rw = 2 * wid + rq, t = t0 + rw;
                LAS int* list = list0 + rq * 256;
                const int nsel = rq ? nsel1 : nsel0;
                const int nch = (nsel + 31) >> 5;
                long qf[8];
#pragma unroll
                for (int ks = 0; ks < 8; ++ks) qf[ks] = *(const long*)(QLt + ((size_t)((l15 * 16 + 2 * ks + (g >> 1)) * 16 + rw)) * 16 + (g & 1) * 8);
                f32x4 o[16];
#pragma unroll
                for (int nt = 0; nt < 16; ++nt) o[nt] = (f32x4){0.f, 0.f, 0.f, 0.f};
                float mrun = -INFINITY, lsum = 0.f;
                const char* Cb = (const char*)(C8 + mb0 * 256);
                const int grow = lnv >> 4;
                const int rw_x = (g >> 1) ^ l15;
                const int rbase = l15 * 256 + 8 * (g & 1);
                const int q8 = l15 >> 1, p2 = lnv & 1; const int tR = q8 < 4 ? 4 * g + q8 : 16 + 4 * g + (q8 - 4);
                const int t_x = (tR & 15) ^ ((tR >> 4) << 3); const int tbase = tR * 256 + 8 * p2;
                const unsigned wlb = (unsigned)(size_t)wl;
#define DSA_GATHER(cc, bufoff) do { \
                    _Pragma("unroll") for (int i_ = 0; i_ < 8; ++i_) { int id_ = list[32 * (cc) + 4 * i_ + grow]; id_ = id_ < 0 ? 0 : (id_ & 0xffff); \
                        const unsigned off_ = (unsigned)id_ * 256u + (gsw ^ (unsigned)(((4 * (i_ & 3)) ^ ((i_ >> 2) << 3)) << 4)); \
                        __builtin_amdgcn_global_load_lds((const unsigned*)(Cb + off_), (LAS unsigned*)(wl + (bufoff) + i_ * 1024), 16, 0, 0); } } while (0)
                const unsigned gsw = (unsigned)(((lnv & 15) ^ grow) << 4);
                asm volatile("s_waitcnt lgkmcnt(0)" ::: "memory");
                if (nch > 0) DSA_GATHER(0, 0);
                for (int c = 0; c < nch; ++c) {
                    const int bo = (c & 1) * 8192;
                    if (c + 1 < nch) { DSA_GATHER(c + 1, 8192 - bo); asm volatile("s_waitcnt vmcnt(8)" ::: "memory"); }
                    else asm volatile("s_waitcnt vmcnt(0)" ::: "memory");
                    f32x4 st[2];
#pragma unroll
                    for (int kt = 0; kt < 2; ++kt) { f32x4 acc = {0.f, 0.f, 0.f, 0.f};
#pragma unroll
                        for (int ks = 0; ks < 8; ++ks) { const long a8 = *(const LAS long*)(wl + bo + kt * 4096 + rbase + ((((2 * ks) ^ (8 * kt)) ^ rw_x) << 4)); acc = __builtin_amdgcn_mfma_f32_16x16x32_fp8_fp8(a8, qf[ks], acc, 0, 0, 0); }
                        st[kt] = acc; }
                    float cm = -INFINITY;
#pragma unroll
                    for (int kt = 0; kt < 2; ++kt) { const v4u id4 = *(const LAS v4u*)(list + 32 * c + 16 * kt + 4 * g);
#pragma unroll
                        for (int i = 0; i < 4; ++i) { const int e = (int)id4[i];
                            const float s = e >= 0 ? st[kt][i] * (0.125f * L2E) + t5l[(e >> 16) * 16 + l15] : -INFINITY; st[kt][i] = s; cm = fmaxf(cm, s); } }
                    cm = fmaxf(cm, __shfl_xor(cm, 16)); cm = fmaxf(cm, __shfl_xor(cm, 32));
                    const float mnew = fmaxf(mrun, cm), alpha = __builtin_amdgcn_exp2f(mrun - mnew); mrun = mnew;
                    float ps = 0.f;
#pragma unroll
                    for (int kt = 0; kt < 2; ++kt)
#pragma unroll
                        for (int i = 0; i < 4; ++i) { st[kt][i] = __builtin_amdgcn_exp2f(st[kt][i] - mnew); ps += st[kt][i]; }
                    lsum = lsum * alpha + ps;
                    if (__any(alpha != 1.0f)) {
#pragma unroll
                        for (int nt = 0; nt < 16; ++nt) o[nt] *= alpha;
                    }
                    int plo = __builtin_amdgcn_cvt_pk_fp8_f32(st[0][0], st[0][1], 0, false); plo = __builtin_amdgcn_cvt_pk_fp8_f32(st[0][2], st[0][3], plo, true);
                    int phi = __builtin_amdgcn_cvt_pk_fp8_f32(st[1][0], st[1][1], 0, false); phi = __builtin_amdgcn_cvt_pk_fp8_f32(st[1][2], st[1][3], phi, true);
                    const long pb = (long)(((unsigned long long)(unsigned)phi << 32) | (unsigned)plo);
#pragma unroll
                    for (int nq = 0; nq < 2; ++nq) {
                        long a8[8];
#pragma unroll
                        for (int k = 0; k < 8; ++k) { const int nt = 8 * nq + k; const unsigned ad = wlb + bo + tbase + (((nt ^ t_x)) << 4);
                            asm volatile("ds_read_b64_tr_b8 %0, %1" : "=&v"(a8[k]) : "v"(ad) : "memory"); }
                        asm volatile("s_waitcnt lgkmcnt(0)" ::: "memory"); __builtin_amdgcn_sched_barrier(0);
#pragma unroll
                        for (int k = 0; k < 8; ++k) o[8 * nq + k] = __builtin_amdgcn_mfma_f32_16x16x32_fp8_fp8(a8[k], pb, o[8 * nq + k], 0, 0, 0);
                    }
                }
#undef DSA_GATHER
                lsum += __shfl_xor(lsum, 16); lsum += __shfl_xor(lsum, 32);
                const float inv = 1.f / lsum;
#pragma unroll
                for (int nt = 0; nt < 16; ++nt) { const f32x4 y = o[nt] * (inv * 16.0f);
                    int p8 = __builtin_amdgcn_cvt_pk_fp8_f32(y[0], y[1], 0, false); p8 = __builtin_amdgcn_cvt_pk_fp8_f32(y[2], y[3], p8, true);
                    *(int*)(OLt + ((size_t)((rw * 16 + nt) * 16 + l15)) * 16 + 4 * g) = p8; }
            }
            __syncthreads();
            }
#pragma unroll 1
            for (int hq = 0; hq < 2; ++hq) { const int hh = 2 * wid + hq;
                int l15 = l15_, g = g_; asm volatile("" : "+v"(l15), "+v"(g));
                long ol[4][8];
#pragma unroll
                for (int sub = 0; sub < 4; ++sub)
#pragma unroll
                    for (int ks = 0; ks < 8; ++ks) ol[sub][ks] = *(const long*)(OL + sub * 65536 + ((size_t)((l15 * 16 + 2 * ks + (g >> 1)) * 16 + hh)) * 16 + (g & 1) * 8);
#pragma unroll 1
                for (int dt = 0; dt < 4; ++dt) {
                    const unsigned char* wp = WUVT8 + ((size_t)(hh * 64 + 16 * dt + l15)) * 256 + 8 * g;
                    long wv[8];
#pragma unroll
                    for (int ks = 0; ks < 8; ++ks) wv[ks] = *(const long*)(wp + 32 * ks);
#pragma unroll
                    for (int sub = 0; sub < 4; ++sub) { f32x4 acc = {0.f, 0.f, 0.f, 0.f};
#pragma unroll
                        for (int ks = 0; ks < 8; ++ks) acc = __builtin_amdgcn_mfma_f32_16x16x32_fp8_fp8(wv[ks], ol[sub][ks], acc, 0, 0, 0);
                        acc *= (1.0f / 1024.0f);
                        *(unsigned long long*)(OMIX + (mb0 + 16 * DSA_TQ(sub) + l15) * DM + hh * 64 + 16 * dt + 4 * g) = (unsigned long long)pg8::cvt_pk_bf16(acc[0], acc[1]) | ((unsigned long long)pg8::cvt_pk_bf16(acc[2], acc[3]) << 32); }
                } }
            __syncthreads();
#undef DSA_TQ
        }
    }
}
__device__ __forceinline__ void cnorm_phase(const bf16* PO, const float* gk, unsigned char* C8) {
    const int lane = threadIdx.x & 63, gw = blockIdx.x * 8 + (threadIdx.x >> 6), NGW = gridDim.x * 8;
    const f32x4 gv = *(const f32x4*)(gk + lane * 4);
    for (int m = gw; m < M; m += NGW) {
        const unsigned long long raw = *(const unsigned long long*)(PO + (size_t)m * NO_IN + 1024 + lane * 4);
        const float x0 = bf2f((unsigned short)raw), x1 = bf2f((unsigned short)(raw >> 16)), x2 = bf2f((unsigned short)(raw >> 32)), x3 = bf2f((unsigned short)(raw >> 48));
        const float rstd = rsqrtf(wave_sum(x0 * x0 + x1 * x1 + x2 * x2 + x3 * x3) * (1.f / 256.f) + EPS);
        int p8 = __builtin_amdgcn_cvt_pk_fp8_f32(x0 * rstd * gv.x, x1 * rstd * gv.y, 0, false); p8 = __builtin_amdgcn_cvt_pk_fp8_f32(x2 * rstd * gv.z, x3 * rstd * gv.w, p8, true);
        *(int*)(C8 + (size_t)m * 256 + lane * 4) = p8;
    }
}
}
__device__ __forceinline__ void xb_phase(const float* X, bf16* XB, float* SSQ) {
    const int lane = threadIdx.x & 63, gw = blockIdx.x * 8 + (threadIdx.x >> 6), NGW = gridDim.x * 8;
    for (int m = gw; m < M; m += NGW) {
        const f32x4* xr = (const f32x4*)(X + (size_t)m * DM) + lane;
        f32x4 v[4]; float s = 0.f;
#pragma unroll
        for (int j = 0; j < 4; ++j) { v[j] = xr[64 * j]; s += (v[j].x * v[j].x + v[j].y * v[j].y) + (v[j].z * v[j].z + v[j].w * v[j].w); }
        s = wave_sum(s);
        unsigned long long* o8 = (unsigned long long*)(XB + (size_t)m * DM) + lane;
#pragma unroll
        for (int j = 0; j < 4; ++j) o8[64 * j] = (unsigned long long)pk2(v[j].x, v[j].y) | ((unsigned long long)pk2(v[j].z, v[j].w) << 32);
        if (lane < 16) SSQ[(size_t)m * 16 + lane] = lane == 0 ? s : 0.f;
    }
}
__device__ __forceinline__ void final_norm_phase(const bf16* XB, const float* g, float* out) {
    const int lane = threadIdx.x & 63, gw = blockIdx.x * 8 + (threadIdx.x >> 6), NGW = gridDim.x * 8;
    f32x4 gv[4];
#pragma unroll
    for (int j = 0; j < 2; ++j) { gv[2 * j] = *(const f32x4*)(g + 512 * j + 8 * lane); gv[2 * j + 1] = *(const f32x4*)(g + 512 * j + 8 * lane + 4); }
    for (int m0 = gw * 4; m0 < M; m0 += NGW * 4) {
        v4u raw[4][2];
#pragma unroll
        for (int r = 0; r < 4; ++r)
#pragma unroll
            for (int j = 0; j < 2; ++j) raw[r][j] = *(const v4u*)(XB + (size_t)(m0 + r) * DM + 512 * j + 8 * lane);
#pragma unroll
        for (int r = 0; r < 4; ++r) { f32x4 v[4]; float s = 0.f;
#pragma unroll
            for (int j = 0; j < 2; ++j) { const v4u w = raw[r][j];
                v[2 * j] = (f32x4){__builtin_bit_cast(float, w.x << 16), __builtin_bit_cast(float, w.x & 0xffff0000u), __builtin_bit_cast(float, w.y << 16), __builtin_bit_cast(float, w.y & 0xffff0000u)};
                v[2 * j + 1] = (f32x4){__builtin_bit_cast(float, w.z << 16), __builtin_bit_cast(float, w.z & 0xffff0000u), __builtin_bit_cast(float, w.w << 16), __builtin_bit_cast(float, w.w & 0xffff0000u)}; }
#pragma unroll
            for (int j = 0; j < 4; ++j) s += (v[j].x * v[j].x + v[j].y * v[j].y) + (v[j].z * v[j].z + v[j].w * v[j].w);
            const float rstd = rsqrtf(wave_sum(s) * (1.f / DM) + EPS);
            float* o = out + (size_t)(m0 + r) * DM + 8 * lane;
            *(f32x4*)o = v[0] * rstd * gv[0]; *(f32x4*)(o + 4) = v[1] * rstd * gv[1]; *(f32x4*)(o + 512) = v[2] * rstd * gv[2]; *(f32x4*)(o + 516) = v[3] * rstd * gv[3]; }
    }
}

#define RLX_AGENT __ATOMIC_RELAXED, __HIP_MEMORY_SCOPE_AGENT
typedef GAS unsigned gu32;
#define XB_TMO      128
#define XB_XCNT(j)  (256  + 64 * (j))
#define XB_XSUB(j)  (1280 + 64 * (j))
#define XB_XGEN(j)  (2304 + 64 * (j))
#define XB_TOP      3328
#define XB_TOPGEN   3392
#define XCD_BAR_WORDS 3456
#define XB_SPIN_CAP (1u << 18)

__device__ __forceinline__ unsigned xb_ld(unsigned* p)              { return __hip_atomic_load(p, __ATOMIC_RELAXED, __HIP_MEMORY_SCOPE_AGENT); }
__device__ __forceinline__ unsigned xb_add(unsigned* p, unsigned v) { return __hip_atomic_fetch_add(p, v, __ATOMIC_RELAXED, __HIP_MEMORY_SCOPE_AGENT); }
__device__ __forceinline__ unsigned xb_xcc_id() { return (unsigned)__builtin_amdgcn_s_getreg((3 << 11) | 20) & 0xFu; }
#define XB_SPIN(cond, bar) do { unsigned _sp = 0; while (cond) { __builtin_amdgcn_s_sleep(1); \
    if ((++_sp & 255u) == 0u) { if (xb_ld(&(bar)[XB_TMO])) break; if (_sp > XB_SPIN_CAP) { atomicAdd(&(bar)[XB_TMO], 1u); break; } } } } while (0)

struct XcdBarrier {
    unsigned* bar; unsigned x;
    volatile LAS unsigned* st;
};

__device__ __forceinline__ XcdBarrier xcd_barrier_post(unsigned* bar, volatile LAS unsigned* st) {
    XcdBarrier b; b.bar = bar; b.x = xb_xcc_id(); b.st = st;
    if (threadIdx.x == 0) (void)xb_add(&bar[XB_XCNT(b.x)], 1u);
    return b;
}
__device__ __forceinline__ void xcd_barrier_complete(unsigned* bar, unsigned x, unsigned& nloc, unsigned& nx) {
    const unsigned G = gridDim.x * gridDim.y * gridDim.z;
    unsigned sum, cnt, mine, sp = 0u;
    for (;;) {
        sum = 0u; cnt = 0u; mine = 0u;
#pragma unroll
        for (unsigned j = 0; j < 16; ++j) { const unsigned c = xb_ld(&bar[XB_XCNT(j)]); sum += c; cnt += (c > 0u) ? 1u : 0u; mine = (j == x) ? c : mine; }
        if (sum == G) break;
        __builtin_amdgcn_s_sleep(1);
        if ((++sp & 255u) == 0u) { if (xb_ld(&bar[XB_TMO])) break; if (sp > XB_SPIN_CAP) { atomicAdd(&bar[XB_TMO], 1u); break; } }
    }
    nloc = mine > 0u ? mine : 1u; nx = cnt > 0u ? cnt : 1u;
}

__device__ __forceinline__ void xcd_barrier(const XcdBarrier& b) {
    asm volatile("s_waitcnt vmcnt(0)" ::: "memory");
    __syncthreads();
    if (threadIdx.x == 0) {
        unsigned* bar = b.bar;
        __builtin_amdgcn_s_waitcnt(0);
        unsigned nloc = b.st[0], nx = b.st[1];
        if (nloc == 0u) { xcd_barrier_complete(bar, b.x, nloc, nx); b.st[0] = nloc; b.st[1] = nx; }
        const unsigned old = xb_add(&bar[XB_XSUB(b.x)], 1u);
        const unsigned gen = old / nloc;
        if (old + 1u == (gen + 1u) * nloc) {
            __builtin_amdgcn_fence(__ATOMIC_RELEASE, "agent");
            asm volatile("s_waitcnt vmcnt(0)" ::: "memory");
            const unsigned og = xb_add(&bar[XB_TOP], 1u);
            const unsigned tg = og / nx;
            if (og + 1u == (tg + 1u) * nx) xb_add(&bar[XB_TOPGEN], 1u);
            else XB_SPIN(xb_ld(&bar[XB_TOPGEN]) == tg, bar);
            __builtin_amdgcn_fence(__ATOMIC_ACQUIRE, "agent");
            xb_add(&bar[XB_XGEN(b.x)], 1u);
            asm volatile("s_waitcnt vmcnt(0)" ::: "memory");
        } else {
            XB_SPIN(xb_ld(&bar[XB_XGEN(b.x)]) == gen, bar);
            __builtin_amdgcn_fence(__ATOMIC_ACQUIRE, "agent");
            asm volatile("s_waitcnt vmcnt(0)" ::: "memory");
        }
    }
    __syncthreads();
}


constexpr int NPHASE = 19;
constexpr int LDS_TOTAL = 163840, MISC_OFF = 163840 - 256;
static_assert(dsa::LDS_BYTES <= MISC_OFF && gla::LDS_BYTES <= MISC_OFF && fox::LDS_BYTES <= MISC_OFF, "LDS map");
constexpr int CW_BAR = 4096;
struct Args {
    const float* x; const float* norm_g; const float* ffn_w_in; const float* ffn_w_out; const float* even_w_in; const float* gla_w_gate; const float* gla_b_gate; const float* gla_norm_g;
    const float* fox_b_f; const float* even_w_out; const float* odd_w_in; const float* kv_norm_g; const float* w_uk; const float* w_uv; const float* odd_w_out; const float* t5; const float* final_g;
    float* out; unsigned char* ws; int ph_lo, ph_hi;
};
__device__ __forceinline__ void prologue_phase(LAS unsigned char* lds, const Args& a) {
    const int lane = threadIdx.x & 63, wave = threadIdx.x >> 6;
    LAS float* scr = (LAS float*)lds + wave * 64 * 33;
    const int gw = blockIdx.x * 8 + wave, NGW = gridDim.x * 8;
    unsigned char* ws = a.ws;
#pragma unroll 1
    for (int i = 0; i < 28; ++i) {
        WDesc w;
        if (i < 4) w = WDesc{a.ffn_w_in + (size_t)i * DM * 2 * DFF, (bf16*)(ws + WS_WFI + i * FI_BYTES), a.norm_g + (i == 0 ? 0 : i == 1 ? 2 : i == 2 ? 3 : 5) * DM, DM, 2 * DFF, 2 * DFF, 1};
        else if (i < 8) w = WDesc{a.ffn_w_out + (size_t)(i - 4) * DFF * DM, (bf16*)(ws + WS_WFO + (i - 4) * FO_BYTES), nullptr, DFF, DM, DM, 0};
        else if (i == 8) w = WDesc{a.even_w_in, (bf16*)(ws + WS_WEI), a.norm_g + 1 * DM, DM, 3096, NE_IN, 2};
        else if (i == 9) w = WDesc{a.even_w_out, (bf16*)(ws + WS_WEO), nullptr, DM, DM, DM, 0};
        else if (i == 10) w = WDesc{a.odd_w_in, (bf16*)(ws + WS_WOI), a.norm_g + 4 * DM, DM, 1864, NO_IN, 3};
        else if (i == 11) w = WDesc{a.odd_w_out, (bf16*)(ws + WS_WOO), nullptr, DM, DM, DM, 0};
        else w = WDesc{a.w_uk + (size_t)(i - 12) * 64 * 256, (bf16*)(ws + WS_WUK) + (size_t)(i - 12) * 256 * 64, nullptr, 64, 256, 256, 0};
        const int nitems = (w.Nd / 32) * (w.K / 64);
        for (int it = gw; it < nitems; it += NGW) transpose_item(w, scr, it, lane);
    }
    for (int e4 = blockIdx.x * 512 + threadIdx.x; e4 < 16 * 64 * 64; e4 += gridDim.x * 512) { const int l4 = e4 & 63, d = (e4 >> 6) & 63, hh = e4 >> 12;
        const float* s = a.w_uv + ((size_t)hh * 256 + 4 * l4) * 64 + d;
        int p8 = __builtin_amdgcn_cvt_pk_fp8_f32(s[0] * 64.f, s[64] * 64.f, 0, false); p8 = __builtin_amdgcn_cvt_pk_fp8_f32(s[128] * 64.f, s[192] * 64.f, p8, true);
        *(int*)(ws + WS_WUV + ((size_t)(hh * 64 + d)) * 256 + 4 * l4) = p8; }
}
template <class Epi> __device__ __forceinline__ void gemm_call_norm(LAS unsigned char* lds, const bf16* A, const bf16* Bt, int N, int K, const Epi& E, const float* SSQ) {
    pg8::StaticOrder S; S.init(M, N, (int)gridDim.x, (int)blockIdx.x);
    LAS float* tab = (LAS float*)(lds + pg8::RSTD_LDS_OFF);
    LAS int* pml = (LAS int*)(lds + pg8::RSTD_LDS_OFF + 16384);
    pg8::Unit u; int nu = 0;
    for (; S.next(nu, u) && nu < 16; ++nu) { if (threadIdx.x == 0) pml[nu] = u.pm; }
    __syncthreads();
    f32x4 pv[8][4];
#pragma unroll
    for (int j = 0; j < 8; ++j) { const int idx = threadIdx.x + 512 * j; if (idx < nu * 256) { const int row = pml[idx >> 8] * 256 + (idx & 255); const f32x4* p = (const f32x4*)(SSQ + (size_t)row * 16);
#pragma unroll
            for (int k = 0; k < 4; ++k) pv[j][k] = p[k]; } }
#pragma unroll
    for (int j = 0; j < 8; ++j) { const int idx = threadIdx.x + 512 * j; if (idx < nu * 256) {
            const float s = ((pv[j][0].x + pv[j][0].y) + (pv[j][0].z + pv[j][0].w)) + ((pv[j][1].x + pv[j][1].y) + (pv[j][1].z + pv[j][1].w)) + ((pv[j][2].x + pv[j][2].y) + (pv[j][2].z + pv[j][2].w)) + ((pv[j][3].x + pv[j][3].y) + (pv[j][3].z + pv[j][3].w));
            tab[idx] = rsqrtf(s * (1.f / DM) + EPS); } }
    __syncthreads();
    pg8::Gemm g{A, Bt, M, N, K};
    pg8::gemm_phase<Epi, pg8::StaticOrder, true, true>((PG8_LAS unsigned char*)lds, g, S, E);
}
template <class Epi> __device__ __forceinline__ void gemm_call(LAS unsigned char* lds, const bf16* A, const bf16* Bt, int N, int K, const Epi& E) {
    pg8::Gemm g{A, Bt, M, N, K};
    pg8::StaticOrder S; S.init(M, N, (int)gridDim.x, (int)blockIdx.x);
    pg8::gemm_phase<Epi, pg8::StaticOrder, true, true>((PG8_LAS unsigned char*)lds, g, S, E);
}
__global__ void __launch_bounds__(512, 2) k_mega(Args a) {
    extern __shared__ __attribute__((aligned(16))) unsigned char lds_raw[];
    LAS unsigned char* lds = (LAS unsigned char*)lds_raw;
    volatile LAS unsigned* MISC = (volatile LAS unsigned*)(lds + MISC_OFF);
    for (int u = threadIdx.x; u < (LDS_TOTAL - MISC_OFF) / 4; u += 512) MISC[u] = 0u;
    __syncthreads();
    unsigned char* ws = a.ws;
    XcdBarrier bar = xcd_barrier_post((unsigned*)(ws + WS_CTL) + CW_BAR, MISC + 8);
    const int lo = a.ph_lo, hi = a.ph_hi;
#define IN(k) (lo <= (k) && (k) < hi)
#define SEAM(k) do { if (IN(k) && IN((k) + 1)) xcd_barrier(bar); } while (0)
    float* X = a.out;
    bf16* XB = (bf16*)(ws + WS_HB); bf16* BIG = (bf16*)(ws + WS_BIG); float* TE = (float*)(ws + WS_TE); float* TO = (float*)(ws + WS_TO);
    bf16* OME = (bf16*)(ws + WS_OMIX_EVEN); bf16* OMO = (bf16*)(ws + WS_OMIX_ODD);
    float* F = (float*)(ws + WS_F); float* SSQ = (float*)(ws + WS_SSQ);
#define FFN_BLOCK(k, idx, src) \
    if (IN(k)) { gemm_call_norm(lds, XB, (const bf16*)(ws + WS_WFI + (size_t)(idx) * FI_BYTES), 2 * DFF, DM, pg8::EpiSwiglu{ws}, SSQ); } SEAM(k); \
    if (IN((k) + 1)) { gemm_call(lds, BIG, (const bf16*)(ws + WS_WFO + (size_t)(idx) * FO_BYTES), DM, DFF, pg8::EpiResid{ws, 0.5f}); } SEAM((k) + 1);

    if (IN(0)) { prologue_phase(lds, a); xb_phase(a.x, XB, SSQ); } SEAM(0);
    FFN_BLOCK(1, 0, a.x)
    if (IN(3)) { gemm_call_norm(lds, XB, (const bf16*)(ws + WS_WEI), NE_IN, DM, pg8::EpiProj{ws, NE_BF, 12, 12, WS_TE}, SSQ); } SEAM(3);
    if (IN(4)) { fox::scan_phase(lds, TE, a.fox_b_f, BIG, F, (float*)(ws + WS_KMAX)); gla::g1_phase(lds, BIG, TE, a.gla_w_gate, a.gla_b_gate, (float*)(ws + WS_GU), (float*)(ws + WS_GDEC)); } SEAM(4);
    if (IN(5)) { gla::g2_phase((const float*)(ws + WS_GU), (const float*)(ws + WS_GDEC), (bf16*)(ws + WS_GSP)); fox::phase(lds, BIG, F, (const float*)(ws + WS_KMAX), OME); } SEAM(5);
    if (IN(6)) { gla::g3_phase(lds, BIG, TE, a.gla_w_gate, a.gla_b_gate, (const bf16*)(ws + WS_GSP), a.gla_norm_g, OME); } SEAM(6);
    if (IN(7)) { gemm_call(lds, OME, (const bf16*)(ws + WS_WEO), DM, DM, pg8::EpiResid{ws, 1.0f}); } SEAM(7);
    FFN_BLOCK(8, 1, X)
    FFN_BLOCK(10, 2, X)
    if (IN(12)) { gemm_call_norm(lds, XB, (const bf16*)(ws + WS_WOI), NO_IN, DM, pg8::EpiProj{ws, NO_IN, 8, 7, WS_TO}, SSQ); } SEAM(12);
    if (IN(13)) { dsa::cnorm_phase(BIG, a.kv_norm_g, ws + WS_C); } SEAM(13);
    if (IN(14)) { dsa::phase(lds, BIG, TO, ws + WS_C, (const bf16*)(ws + WS_WUK), ws + WS_WUV, a.t5, ws + WS_DSCR, OMO); } SEAM(14);
    if (IN(15)) { gemm_call(lds, OMO, (const bf16*)(ws + WS_WOO), DM, DM, pg8::EpiResid{ws, 1.0f}); } SEAM(15);
    FFN_BLOCK(16, 3, X)
    if (IN(18)) { final_norm_phase(XB, a.final_g, X); }
#undef IN
#undef SEAM
#undef FFN_BLOCK
}

#ifndef MK_PER_PHASE
#define MK_PER_PHASE 0
#endif
extern "C" void kernel_launch(void* const* d_in, const int* in_sizes, int n_in, void* d_out, int out_size, void* d_ws, size_t ws_size, hipStream_t stream) {
    static int grid = 0;
    if (grid == 0) {
        if (n_in != 17 || ws_size < WS_END || out_size != M * DM) { fprintf(stderr, "kernel_launch: unexpected n_in %d / out_size %d / ws_size %zu; nothing launched\n", n_in, out_size, ws_size); grid = -1; return; }
        int dev = 0, cus = 0, per_cu = 0;
        if (hipGetDevice(&dev) != hipSuccess || hipDeviceGetAttribute(&cus, hipDeviceAttributeMultiprocessorCount, dev) != hipSuccess) { fprintf(stderr, "kernel_launch: device query failed\n"); grid = -1; return; }
        if (hipFuncSetAttribute((const void*)k_mega, hipFuncAttributeMaxDynamicSharedMemorySize, LDS_TOTAL) != hipSuccess) { fprintf(stderr, "kernel_launch: hipFuncSetAttribute failed\n"); grid = -1; return; }
        if (hipOccupancyMaxActiveBlocksPerMultiprocessor(&per_cu, (const void*)k_mega, 512, LDS_TOTAL) != hipSuccess || per_cu < 1) fprintf(stderr, "kernel_launch: occupancy query reports %d blocks per CU\n", per_cu);
        (void)hipGetLastError();
        grid = cus < 256 ? cus : 256;
    }
    if (grid < 0) return;
    if (hipMemsetAsync((char*)d_ws + WS_CTL, 0, 1 * MiB, stream) != hipSuccess) { fprintf(stderr, "kernel_launch: memset failed\n"); return; }
    Args a; memset(&a, 0, sizeof(a));
    a.x = (const float*)d_in[0]; a.norm_g = (const float*)d_in[1]; a.ffn_w_in = (const float*)d_in[2]; a.ffn_w_out = (const float*)d_in[3]; a.even_w_in = (const float*)d_in[4];
    a.gla_w_gate = (const float*)d_in[5]; a.gla_b_gate = (const float*)d_in[6]; a.gla_norm_g = (const float*)d_in[7]; a.fox_b_f = (const float*)d_in[8]; a.even_w_out = (const float*)d_in[9];
    a.odd_w_in = (const float*)d_in[10]; a.kv_norm_g = (const float*)d_in[11]; a.w_uk = (const float*)d_in[12]; a.w_uv = (const float*)d_in[13]; a.odd_w_out = (const float*)d_in[14];
    a.t5 = (const float*)d_in[15]; a.final_g = (const float*)d_in[16]; a.out = (float*)d_out; a.ws = (unsigned char*)d_ws;
#if MK_PER_PHASE
    for (int p = 0; p < NPHASE; ++p) { a.ph_lo = p; a.ph_hi = p + 1; hipLaunchKernelGGL(k_mega, dim3(grid), dim3(512), LDS_TOTAL, stream, a); }
#else
    a.ph_lo = 0; a.ph_hi = NPHASE;
    hipLaunchKernelGGL(k_mega, dim3(grid), dim3(512), LDS_TOTAL, stream, a);
#endif
    const hipError_t le = hipPeekAtLastError();
    if (le != hipSuccess) fprintf(stderr, "kernel_launch: launch failed: %s\n", hipGetErrorName(le));
}
```

```cpp
#include <hip/hip_runtime.h>
#include <cstdio>
#include <cstdint>
#include <cstring>
namespace pg8 {
#define PG8_LAS __attribute__((address_space(3)))
typedef unsigned short bf16_t;
typedef short bf16x8 __attribute__((ext_vector_type(8)));
typedef float f32x4 __attribute__((ext_vector_type(4)));
typedef unsigned u32x4 __attribute__((ext_vector_type(4)));
constexpr int BM = 256, BK = 64, HALF = 128, HTB = HALF * BK * 2  , STAGE_BYTES = 8 * HTB, NXCD = 8, WGM = 8;

__host__ __device__ __forceinline__ int lds_byte(int r, int c) { const int st = (r >> 4) * 2 + (c >> 5), rr = r & 15, cc = c & 31, ob = rr * 64 + cc * 2; return st * 1024 + (ob ^ (((ob >> 9) & 1) << 5)); }
__host__ __device__ __forceinline__ void stage_rc(int b, int& R, int& C) { const int st = b / 1024, sb = b % 1024, swz = sb ^ (((sb >> 9) & 1) << 5); R = (st >> 1) * 16 + swz / 64; C = (st & 1) * 32 + (swz % 64) / 2; }
__host__ __device__ __forceinline__ int perm32(int rho) { const int n = rho >> 4, i = rho & 15; return 8 * (i >> 2) + 4 * n + (i & 3); }

struct Unit { int pm, pn, ord; };
struct Gemm { const bf16_t* A; const bf16_t* Bt; int M, N, K; };

struct StaticOrder {
    int nM, nN, nwg, G, c;
    __host__ __device__ void init(int M, int N, int G_, int c_) { nM = M / BM; nN = N / BM; nwg = nM * nN; G = G_; c = c_; }
    __host__ __device__ bool next(int i, Unit& u) const {
        const long L = (long)i * G + c; if (L >= nwg) return false;
        int wgid = (int)L; { const int q = nwg / NXCD, r = nwg % NXCD, xcd = wgid % NXCD, off = wgid / NXCD; wgid = (xcd < r ? xcd * (q + 1) : r * (q + 1) + (xcd - r) * q) + off; }
        const int nig = WGM * nN, gid = wgid / nig, fm = gid * WGM, gsz = (nM - fm) < WGM ? (nM - fm) : WGM;
        u.pm = fm + ((wgid % nig) % gsz); u.pn = (wgid % nig) / gsz; u.ord = i; return true;
    }
    __device__ __forceinline__ void a_ready(const Unit&) const {}
    __device__ __forceinline__ void done(const Unit&) const {}
};

typedef float f32x2_t __attribute__((ext_vector_type(2))); typedef __bf16 bf16x2_t __attribute__((ext_vector_type(2)));
__device__ __forceinline__ unsigned cvt_pk_bf16(float lo, float hi) { f32x2_t v = {lo, hi}; bf16x2_t b = __builtin_convertvector(v, bf16x2_t); return __builtin_bit_cast(unsigned, b); }
__device__ __forceinline__ float silu_f(float a) { return a * __builtin_amdgcn_rcpf(1.0f + __builtin_amdgcn_exp2f(-1.4426950408889634f * a)); }

template <class Epi, class Sched, bool ALIGN_EPI = false, bool SP2 = false>
__device__ __forceinline__ void gemm_phase(PG8_LAS unsigned char* lds, const Gemm g, const Sched& S, const Epi& E) {
    const int tid = threadIdx.x, wid = __builtin_amdgcn_readfirstlane(tid >> 6), lane = tid & 63, wr = wid >> 2, wc = wid & 3, fr = lane & 15, fq = lane >> 4;
    const int K = g.K, nt = K / BK;
    unsigned voffA[2], voffB[2];
#pragma unroll
    for (int i = 0; i < 2; ++i) { int R, C; stage_rc(tid * 16 + i * 8192, R, C); const int Rb = Epi::PERM ? ((R & ~31) + perm32(R & 31)) : R;
        voffA[i] = (unsigned)(R * K + C) * 2u; voffB[i] = (unsigned)(Rb * K + C) * 2u; }
    const size_t kstep = (size_t)(BK * 2);
    const size_t hstep = (size_t)HALF * K * 2;
    const size_t tstep = 2 * hstep;
    const unsigned ldsw = (unsigned)wid * 1024u;
    const int aoff = lds_byte(wr * 64 + fr, fq * 8), boff = lds_byte(wc * 32 + fr, fq * 8);
#define PG8_SA(b, h) (((b) * 2 + (h)) * HTB)
#define PG8_SB(b, h) ((4 + (b) * 2 + (h)) * HTB)
#define PG8_STAGE(bufoff, gbase, voff) do { _Pragma("unroll") for (int _i = 0; _i < 2; ++_i) \
        __builtin_amdgcn_global_load_lds((const unsigned*)((const char*)(gbase) + (voff)[_i]), (PG8_LAS unsigned*)(lds + (bufoff) + ldsw + _i * 8192), 16, 0, 0); } while (0)
#define PG8_LDA(dst, b, h) do { _Pragma("unroll") for (int m = 0; m < 4; ++m) _Pragma("unroll") for (int k = 0; k < 2; ++k) dst[m][k] = *(const PG8_LAS bf16x8*)(lds + PG8_SA(b, h) + aoff + m * 2048 + k * 1024); } while (0)
#define PG8_LDB(dst, b, h) do { _Pragma("unroll") for (int n = 0; n < 2; ++n) _Pragma("unroll") for (int k = 0; k < 2; ++k) dst[n][k] = *(const PG8_LAS bf16x8*)(lds + PG8_SB(b, h) + boff + n * 2048 + k * 1024); } while (0)
#define PG8_MMA(ai, bj, At, Bt) do { __builtin_amdgcn_s_setprio(1); _Pragma("unroll") for (int m = 0; m < 4; ++m) _Pragma("unroll") for (int n = 0; n < 2; ++n) _Pragma("unroll") for (int k = 0; k < 2; ++k) \
        acc[ai][bj][m][n] = __builtin_amdgcn_mfma_f32_16x16x32_bf16(Bt[n][k], At[m][k], acc[ai][bj][m][n], 0, 0, 0); __builtin_amdgcn_s_setprio(0); } while (0)
#define PG8_WAIT_V(n) asm volatile("s_waitcnt vmcnt(" #n ")" ::: "memory")
#define PG8_WAIT_L(n) asm volatile("s_waitcnt lgkmcnt(" #n ")" ::: "memory")
#define PG8_BAR __builtin_amdgcn_s_barrier()
#define PG8_SCHED __builtin_amdgcn_sched_barrier(0)
    Unit cur, nxt; int ui = 0;
    if (!S.next(0, cur)) return;
    f32x4 acc[2][2][4][2];
#pragma unroll
    for (int a = 0; a < 2; ++a)
#pragma unroll
        for (int b = 0; b < 2; ++b)
#pragma unroll
            for (int m = 0; m < 4; ++m)
#pragma unroll
                for (int n = 0; n < 2; ++n) acc[a][b][m][n] = (f32x4){0.f, 0.f, 0.f, 0.f};
    bf16x8 At[4][2], B0[2][2], B1[2][2];
    const char* cA = (const char*)g.A + (size_t)cur.pm * tstep; const char* cB = (const char*)g.Bt + (size_t)cur.pn * tstep;
    S.a_ready(cur);
    if constexpr (SP2) {
        PG8_STAGE(PG8_SB(0, 0), cB, voffB); PG8_STAGE(PG8_SB(0, 1), cB + hstep, voffB); PG8_STAGE(PG8_SA(0, 0), cA, voffA); PG8_STAGE(PG8_SA(0, 1), cA + hstep, voffA);
        if (wr == 1) PG8_BAR;
        PG8_WAIT_V(2); PG8_BAR;
        PG8_STAGE(PG8_SB(1, 0), cB + kstep, voffB); PG8_STAGE(PG8_SA(1, 0), cA + kstep, voffA); PG8_STAGE(PG8_SB(1, 1), cB + hstep + kstep, voffB);
        PG8_WAIT_V(6); PG8_BAR;
    } else {
        PG8_STAGE(PG8_SB(0, 0), cB, voffB); PG8_STAGE(PG8_SA(0, 0), cA, voffA); PG8_STAGE(PG8_SB(0, 1), cB + hstep, voffB); PG8_STAGE(PG8_SA(0, 1), cA + hstep, voffA);
        if (wr == 1) PG8_BAR;
        PG8_WAIT_V(4); PG8_BAR;
        PG8_STAGE(PG8_SB(1, 0), cB + kstep, voffB); PG8_STAGE(PG8_SA(1, 0), cA + kstep, voffA); PG8_STAGE(PG8_SB(1, 1), cB + hstep + kstep, voffB);
        PG8_WAIT_V(6); PG8_BAR;
    }
    for (;;) {
        const bool has_next = S.next(ui + 1, nxt);
        const char* nA = has_next ? (const char*)g.A + (size_t)nxt.pm * tstep : cA; const char* nB = has_next ? (const char*)g.Bt + (size_t)nxt.pn * tstep : cB;
        for (int t = 0; t < nt; t += 2) {
            const bool last = (t == nt - 2);
            const char* a1 = cA + (size_t)(t + 1) * kstep;
            const char* a2 = last ? nA : cA + (size_t)(t + 2) * kstep; const char* b2 = last ? nB : cB + (size_t)(t + 2) * kstep;
            const char* a3 = a2 + kstep; const char* b3 = b2 + kstep;
            if (last && has_next) S.a_ready(nxt);
            if constexpr (SP2) {
            PG8_LDB(B0, 0, 0); PG8_LDB(B1, 0, 1); PG8_SCHED; PG8_LDA(At, 0, 0); PG8_STAGE(PG8_SA(1, 1), a1 + hstep, voffA);
            PG8_WAIT_V(8); PG8_WAIT_L(0); PG8_BAR; PG8_MMA(0, 0, At, B0); PG8_MMA(0, 1, At, B1); PG8_BAR; PG8_SCHED;
            PG8_LDA(At, 0, 1); PG8_STAGE(PG8_SB(0, 0), b2, voffB); PG8_STAGE(PG8_SB(0, 1), b2 + hstep, voffB); PG8_STAGE(PG8_SA(0, 0), a2, voffA);
            PG8_WAIT_V(8); PG8_WAIT_L(0); PG8_BAR; PG8_MMA(1, 0, At, B0); PG8_MMA(1, 1, At, B1); PG8_BAR; PG8_SCHED;
            PG8_LDB(B0, 1, 0); PG8_LDB(B1, 1, 1); PG8_SCHED; PG8_LDA(At, 1, 0); PG8_STAGE(PG8_SA(0, 1), a2 + hstep, voffA);
            PG8_WAIT_V(8); PG8_WAIT_L(0); PG8_BAR; PG8_MMA(0, 0, At, B0); PG8_MMA(0, 1, At, B1); PG8_BAR; PG8_SCHED;
            PG8_LDA(At, 1, 1); PG8_STAGE(PG8_SB(1, 0), b3, voffB); PG8_STAGE(PG8_SB(1, 1), b3 + hstep, voffB); PG8_STAGE(PG8_SA(1, 0), a3, voffA);
            PG8_WAIT_V(8); PG8_WAIT_L(0); PG8_BAR; PG8_MMA(1, 0, At, B0); PG8_MMA(1, 1, At, B1); PG8_BAR; PG8_SCHED;
            } else {
            PG8_LDB(B0, 0, 0); PG8_SCHED; PG8_LDA(At, 0, 0); PG8_STAGE(PG8_SA(1, 1), a1 + hstep, voffA);
            PG8_WAIT_L(8); PG8_BAR; PG8_WAIT_L(0); PG8_MMA(0, 0, At, B0); PG8_BAR; PG8_SCHED;
            PG8_LDB(B1, 0, 1); PG8_STAGE(PG8_SB(0, 0), b2, voffB);
            PG8_BAR; PG8_WAIT_L(0); PG8_MMA(0, 1, At, B1); PG8_BAR;
            PG8_LDA(At, 0, 1); PG8_STAGE(PG8_SA(0, 0), a2, voffA);
            PG8_BAR; PG8_WAIT_L(0); PG8_MMA(1, 0, At, B0); PG8_BAR; PG8_SCHED;
            PG8_STAGE(PG8_SB(0, 1), b2 + hstep, voffB);
            PG8_WAIT_V(6); PG8_BAR; PG8_MMA(1, 1, At, B1); PG8_BAR;
            PG8_LDB(B0, 1, 0); PG8_SCHED; PG8_LDA(At, 1, 0); PG8_STAGE(PG8_SA(0, 1), a2 + hstep, voffA);
            PG8_WAIT_L(8); PG8_BAR; PG8_WAIT_L(0); PG8_MMA(0, 0, At, B0); PG8_BAR; PG8_SCHED;
            PG8_LDB(B1, 1, 1); PG8_STAGE(PG8_SB(1, 0), b3, voffB);
            PG8_BAR; PG8_WAIT_L(0); PG8_MMA(0, 1, At, B1); PG8_BAR;
            PG8_LDA(At, 1, 1); PG8_STAGE(PG8_SA(1, 0), a3, voffA);
            PG8_BAR; PG8_WAIT_L(0); PG8_MMA(1, 0, At, B0); PG8_BAR; PG8_SCHED;
            PG8_STAGE(PG8_SB(1, 1), b3 + hstep, voffB);
            PG8_WAIT_V(6); PG8_BAR; PG8_MMA(1, 1, At, B1); PG8_BAR;
            }
        }
        if constexpr (ALIGN_EPI) { if (wr == 0) PG8_BAR; }
        if constexpr (!Epi::AFTER_DRAIN) { E(acc, cur, wr, wc, fr, fq); S.done(cur); }
        if (!has_next) break;
#pragma unroll
        for (int a = 0; a < 2; ++a)
#pragma unroll
            for (int b = 0; b < 2; ++b)
#pragma unroll
                for (int m = 0; m < 4; ++m)
#pragma unroll
                    for (int n = 0; n < 2; ++n) acc[a][b][m][n] = (f32x4){0.f, 0.f, 0.f, 0.f};
        cur = nxt; cA = nA; cB = nB; ++ui;
        if constexpr (ALIGN_EPI) { if (wr == 1) PG8_BAR; }
    }
    PG8_WAIT_V(0);
    if constexpr (!ALIGN_EPI) { if (wr == 0) PG8_BAR; }
    PG8_BAR;
    if constexpr (Epi::AFTER_DRAIN) { E.fused(acc, cur, wr, wc, fr, fq, lds, wid, lane); S.done(cur); }
#undef PG8_SA
#undef PG8_SB
#undef PG8_STAGE
#undef PG8_LDA
#undef PG8_LDB
#undef PG8_MMA
#undef PG8_WAIT_V
#undef PG8_WAIT_L
#undef PG8_BAR
#undef PG8_SCHED
}
}
constexpr int BATCH = 8, SEQ = 4096, DM = 1024, M = BATCH * SEQ, DFF = 2816;
constexpr int NE_IN = 3328, NE_BF = 3072, NO_IN = 2048;
constexpr float EPS = 1e-6f;
typedef unsigned short bf16;
typedef unsigned v4u __attribute__((ext_vector_type(4)));
typedef float f32x4 __attribute__((ext_vector_type(4)));
#define LAS __attribute__((address_space(3)))
#define GAS __attribute__((address_space(1)))
constexpr size_t MiB = 1u << 20;
constexpr size_t WS_CTL = 0, WS_KMAX = 524288, WS_F = 1 * MiB;
constexpr size_t WS_WFI = 2 * MiB, WS_WFO = 46 * MiB, WS_WEI = 68 * MiB, WS_WEO = 75 * MiB, WS_WOI = 77 * MiB, WS_WOO = 81 * MiB;
constexpr size_t WS_WUK = 83 * MiB, WS_WUV = 83 * MiB + 524288;
constexpr size_t WS_HB = 84 * MiB;
constexpr size_t WS_BIG = 148 * MiB;
constexpr size_t WS_TE = WS_BIG + 192 * MiB, WS_TO = WS_BIG + 128 * MiB;
constexpr size_t WS_OMIX_ODD = WS_BIG + 132 * MiB;
constexpr size_t WS_AUX = 344 * MiB;
constexpr size_t WS_C = WS_AUX;
constexpr size_t WS_GU = WS_AUX, WS_GSP = WS_AUX + 64 * MiB, WS_GDEC = WS_AUX + 96 * MiB, WS_DSCR = WS_AUX + 16 * MiB;
constexpr size_t WS_OMIX_EVEN = WS_AUX + 100 * MiB, WS_SSQ = WS_AUX + 164 * MiB;
constexpr size_t WS_END = 512 * MiB;
constexpr size_t FI_BYTES = (size_t)2 * DFF * DM * 2, FO_BYTES = (size_t)DM * DFF * 2;

__device__ __forceinline__ unsigned f2bf(float f) { return pg8::cvt_pk_bf16(f, 0.f) & 0xffffu; }
__device__ __forceinline__ unsigned pk2(float lo, float hi) { return pg8::cvt_pk_bf16(lo, hi); }
__device__ __forceinline__ float bf2f(unsigned short b) { return __builtin_bit_cast(float, (unsigned)b << 16); }
__device__ __forceinline__ float wave_sum(float v) {
#pragma unroll
    for (int o = 1; o < 64; o <<= 1) v += __shfl_xor(v, o);
    return v;
}
__device__ __forceinline__ float wave_max(float v) {
#pragma unroll
    for (int o = 1; o < 64; o <<= 1) v = fmaxf(v, __shfl_xor(v, o));
    return v;
}
__device__ __forceinline__ float exp_hw(float x) { return __builtin_amdgcn_exp2f(x * 1.4426950408889634f); }
__device__ __forceinline__ float log_sigmoid(float x) { return fminf(x, 0.f) - 0.6931471805599453f * __builtin_amdgcn_logf(1.f + __builtin_amdgcn_exp2f(-1.4426950408889634f * fabsf(x))); }

namespace pg8 {
constexpr int RSTD_LDS_OFF = 131072;
__device__ __forceinline__ float row_rstd(const float* SSQ, int row, int fq) {
    const f32x4 p = *(const f32x4*)(SSQ + (size_t)row * 16 + 4 * fq);
    float s = (p.x + p.y) + (p.z + p.w);
    s += __shfl_xor(s, 16); s += __shfl_xor(s, 32);
    return rsqrtf(s * (1.f / 1024.f) + 1e-6f);
}
struct EpiSwiglu {
    static constexpr bool PERM = true, AFTER_DRAIN = false;
    unsigned char* ws;
    __device__ __forceinline__ void operator()(const f32x4 (&acc)[2][2][4][2], const Unit& u, int wr, int wc, int fr, int fq) const {
        bf16_t* O = (bf16_t*)(ws + WS_BIG); constexpr int ldc = DFF; const PG8_LAS float* tab = (const PG8_LAS float*)RSTD_LDS_OFF + u.ord * 256;
        int fqv = fq, frv = fr; asm volatile("" : "+v"(fqv), "+v"(frv));
        const int row0 = u.pm * BM + wr * 64 + frv, col0 = u.pn * HALF + wc * 32 + 8 * fqv;
#pragma unroll
        for (int ai = 0; ai < 2; ++ai)
#pragma unroll
            for (int m = 0; m < 4; ++m) { const int row = row0 + ai * HALF + m * 16; bf16_t* rowp = O + (size_t)row * ldc + col0;
                const float rs = tab[(row0 & 255) + ai * HALF + m * 16];
                const f32x4 a0 = acc[ai][0][m][0] * rs, a1 = acc[ai][0][m][1] * rs, b0 = acc[ai][1][m][0] * rs, b1 = acc[ai][1][m][1] * rs;
                u32x4 w; w.x = cvt_pk_bf16(silu_f(a0[0]) * b0[0], silu_f(a0[1]) * b0[1]); w.y = cvt_pk_bf16(silu_f(a0[2]) * b0[2], silu_f(a0[3]) * b0[3]);
                w.z = cvt_pk_bf16(silu_f(a1[0]) * b1[0], silu_f(a1[1]) * b1[1]); w.w = cvt_pk_bf16(silu_f(a1[2]) * b1[2], silu_f(a1[3]) * b1[3]);
                *(u32x4*)rowp = w; }
    }
};
struct EpiResid {
    static constexpr bool PERM = true, AFTER_DRAIN = false;
    unsigned char* ws; float scale;
    __device__ __forceinline__ void operator()(const f32x4 (&acc)[2][2][4][2], const Unit& u, int wr, int wc, int fr, int fq) const {
        bf16_t* XB = (bf16_t*)(ws + WS_HB); float* SSQ = (float*)(ws + WS_SSQ); constexpr int ldc = DM;
        int fqv = fq, frv = fr; asm volatile("" : "+v"(fqv), "+v"(frv));
        const int row0 = u.pm * BM + wr * 64 + frv, col0 = u.pn * BM + wc * 32 + 8 * fqv;
        u32x4 bv[2][4][2];
#pragma unroll
        for (int ai = 0; ai < 2; ++ai)
#pragma unroll
            for (int m = 0; m < 4; ++m)
#pragma unroll
                for (int bj = 0; bj < 2; ++bj) bv[ai][m][bj] = *(const u32x4*)(XB + (size_t)(row0 + ai * HALF + m * 16) * ldc + col0 + bj * HALF);
#pragma unroll
        for (int ai = 0; ai < 2; ++ai)
#pragma unroll
            for (int m = 0; m < 4; ++m) { const int row = row0 + ai * HALF + m * 16; bf16_t* rowp = XB + (size_t)row * ldc + col0; float s = 0.f;
#pragma unroll
                for (int bj = 0; bj < 2; ++bj) { const u32x4 b = bv[ai][m][bj]; const f32x4 a0 = acc[ai][bj][m][0] * scale, a1 = acc[ai][bj][m][1] * scale;
                    float y[8];
                    y[0] = __builtin_bit_cast(float, b.x << 16) + a0[0]; y[1] = __builtin_bit_cast(float, b.x & 0xffff0000u) + a0[1];
                    y[2] = __builtin_bit_cast(float, b.y << 16) + a0[2]; y[3] = __builtin_bit_cast(float, b.y & 0xffff0000u) + a0[3];
                    y[4] = __builtin_bit_cast(float, b.z << 16) + a1[0]; y[5] = __builtin_bit_cast(float, b.z & 0xffff0000u) + a1[1];
                    y[6] = __builtin_bit_cast(float, b.w << 16) + a1[2]; y[7] = __builtin_bit_cast(float, b.w & 0xffff0000u) + a1[3];
                    u32x4 w; w.x = cvt_pk_bf16(y[0], y[1]); w.y = cvt_pk_bf16(y[2], y[3]); w.z = cvt_pk_bf16(y[4], y[5]); w.w = cvt_pk_bf16(y[6], y[7]);
                    *(u32x4*)(rowp + bj * HALF) = w;
                    s += ((y[0] * y[0] + y[1] * y[1]) + (y[2] * y[2] + y[3] * y[3])) + ((y[4] * y[4] + y[5] * y[5]) + (y[6] * y[6] + y[7] * y[7])); }
                s += __shfl_xor(s, 16); s += __shfl_xor(s, 32);
                if (fqv == 0) SSQ[(size_t)row * 16 + u.pn * 4 + wc] = s; }
    }
};
struct EpiProj {
    static constexpr bool PERM = true, AFTER_DRAIN = false;
    unsigned char* ws; int ldc; int nbf; int tail_pn; size_t toff;
    __device__ __forceinline__ void operator()(const f32x4 (&acc)[2][2][4][2], const Unit& u, int wr, int wc, int fr, int fq) const {
        bf16_t* O = (bf16_t*)(ws + WS_BIG); float* T = (float*)(ws + toff); constexpr int ldt = 32, tail_wc = 1; const PG8_LAS float* tab = (const PG8_LAS float*)RSTD_LDS_OFF + u.ord * 256;
        int fqv = fq, frv = fr; asm volatile("" : "+v"(fqv), "+v"(frv));
        const int row0 = u.pm * BM + wr * 64 + frv, col0 = u.pn * BM + wc * 32 + 8 * fqv;
        const bool do_bf = u.pn < nbf, do_tail = (u.pn == tail_pn && wc < tail_wc);
#pragma unroll
        for (int ai = 0; ai < 2; ++ai)
#pragma unroll
            for (int m = 0; m < 4; ++m) { const int row = row0 + ai * HALF + m * 16; const float rs = tab[(row0 & 255) + ai * HALF + m * 16];
                if (do_bf) { bf16_t* rowp = O + (size_t)row * ldc + col0;
#pragma unroll
                    for (int bj = 0; bj < 2; ++bj) { const f32x4 v0 = acc[ai][bj][m][0] * rs, v1 = acc[ai][bj][m][1] * rs;
                        u32x4 w; w.x = cvt_pk_bf16(v0[0], v0[1]); w.y = cvt_pk_bf16(v0[2], v0[3]); w.z = cvt_pk_bf16(v1[0], v1[1]); w.w = cvt_pk_bf16(v1[2], v1[3]);
                        *(u32x4*)(rowp + bj * HALF) = w; } }
                if (do_tail) { float* rowp = T + (size_t)row * ldt + wc * 32 + 8 * fqv;
                    *(f32x4*)rowp = acc[ai][0][m][0] * rs; *(f32x4*)(rowp + 4) = acc[ai][0][m][1] * rs; } }
    }
};

}
struct WDesc { const float* src; bf16* dst; const float* gk; int K, Ns, Nd, kind; };
__device__ __forceinline__ int src_col(int kind, int n, int Ns) {
    if (kind == 1) { const int j = n >> 8, r = n & 255; return r < 128 ? 128 * j + r : DFF + 128 * j + (r - 128); }
    if (kind == 2) { if (n < 1536) return n; if (n < 3072) return n + 16; if (n < 3088) return 1536 + (n - 3072); if (n < 3096) return n; return -1; }
    if (kind == 3) { if (n < 1792) return n; if (n < 1800) return 1856 + (n - 1792); if (n < 1864) return 1792 + (n - 1800); return -1; }
    return n < Ns ? n : -1;
}
__device__ __forceinline__ void transpose_item(const WDesc& w, LAS float* scr, int item, int lane) {
    const int nblk = w.Nd / 32, kb = item / nblk, nb = item % nblk, k0 = 64 * kb, n0 = 32 * nb;
    const int sc = src_col(w.kind, n0 + (lane & 31), w.Ns);
    const int scc = sc >= 0 ? sc : 0; const float msk = sc >= 0 ? 1.f : 0.f;
    const float* sp = w.src + (size_t)(k0 + (lane >> 5)) * w.Ns + scc;
    float tv[32];
#pragma unroll
    for (int i = 0; i < 32; ++i) tv[i] = sp[(size_t)(2 * i) * w.Ns];
    if (w.gk) {
#pragma unroll
        for (int i = 0; i < 32; ++i) tv[i] *= w.gk[k0 + 2 * i + (lane >> 5)];
    }
#pragma unroll
    for (int i = 0; i < 32; ++i) scr[(2 * i + (lane >> 5)) * 33 + (lane & 31)] = tv[i] * msk;
    asm volatile("s_waitcnt lgkmcnt(0)" ::: "memory");
    const int c = lane & 7;
#pragma unroll
    for (int j = 0; j < 4; ++j) { const int n = (lane >> 3) + 8 * j; const LAS float* s = scr + (8 * c) * 33 + n;
        v4u o; o.x = pk2(s[0 * 33], s[1 * 33]); o.y = pk2(s[2 * 33], s[3 * 33]); o.z = pk2(s[4 * 33], s[5 * 33]); o.w = pk2(s[6 * 33], s[7 * 33]);
        *(v4u*)(w.dst + (size_t)(n0 + n) * w.K + k0 + 8 * c) = o; }
    asm volatile("s_waitcnt lgkmcnt(0)" ::: "memory");
}
__device__ __forceinline__ unsigned ord_key(float x) { const unsigned u = __builtin_bit_cast(unsigned, x); return (u & 0x80000000u) ? ~u : (u | 0x80000000u); }
__device__ __forceinline__ int t5_bucket(int dist) {
    if (dist < 16) return dist;
    const int large = 16 + (int)(logf((float)dist * (1.f / 16.f)) / 2.0794415416798357f * 16.f);
    return large < 31 ? large : 31;
}
namespace fox {
typedef short bf16x8 __attribute__((ext_vector_type(8)));
typedef short s16x4 __attribute__((ext_vector_type(4)));
typedef float f32x16 __attribute__((ext_vector_type(16)));
constexpr int PITCH = NE_BF;
constexpr float C2 = 0.125f * 1.4426950408889634f, L2E = 1.4426950408889634f;
constexpr int L_K = 0, L_V = 16384, L_NB = 32768, L_AL = 49152, L_MM = 50176, LDS_BYTES = 50432;
__device__ __forceinline__ int crow(int r, int hi) { return (r & 3) + 8 * (r >> 2) + 4 * hi; }
__device__ __forceinline__ unsigned cvtpk(float lo, float hi) { return pg8::cvt_pk_bf16(lo, hi); }

__device__ __forceinline__ void attn_unit(int b, int h, int qb, const bf16* PE, const float* F, const float* KMAX, bf16* OMIX, LAS unsigned char* lds) {
    const int tid = threadIdx.x, lane = tid & 63, r32 = lane & 31, hi = lane >> 5; const int wid = __builtin_amdgcn_readfirstlane(tid >> 6);
    const size_t rowbase = (size_t)b * SEQ; const int q0 = qb * 256;
    const bf16* Qw = PE + (rowbase + q0 + wid * 32) * PITCH + 1536 + h * 64;
    const bf16* Kh = PE + rowbase * PITCH + 2048 + h * 64; const bf16* Vh = Kh + 512;
    const float* Fr = F + (size_t)(b * 8 + h) * SEQ;
    LAS float* nb = (LAS float*)(lds + L_NB);
    LAS float* al = (LAS float*)(lds + L_AL) + wid * 32;
    const float Fq0 = Fr[q0];
    for (int s = tid; s < q0 + 256; s += 512) nb[s] = (Fq0 - Fr[s]) * L2E;
    bf16x8 qr[4];
#pragma unroll
    for (int d0 = 0; d0 < 4; ++d0) qr[d0] = *(const bf16x8*)(Qw + (size_t)r32 * PITCH + d0 * 16 + hi * 8);
    const int NT = (q0 + 256) / 64;
    float qkb;
    { float s2 = 0.f;
#pragma unroll
        for (int d0 = 0; d0 < 4; ++d0)
#pragma unroll
            for (int e = 0; e < 8; ++e) { const float qv = bf2f((unsigned short)qr[d0][e]); s2 += qv * qv; }
        s2 += __shfl_xor(s2, 32);
        qkb = C2 * sqrtf(s2) * sqrtf(KMAX[b * 8 + h]) * 1.001f + 38.0f; }
    LAS int* MM = (LAS int*)(lds + L_MM);
    const int qrow = q0 + wid * 32 + r32;
    const int wtop = (q0 + wid * 32 + 31) >> 6;
    const bf16* ksrc = Kh + (size_t)lane * PITCH + wid * 8;
    const bf16* vsrc = Vh + (size_t)(16 * (wid & 3) + (lane >> 2)) * PITCH + (wid >> 2) * 32 + (lane & 3) * 8;
    const int stg = wid * 1024 + lane * 16;
    v4u kreg = *(const v4u*)(ksrc + (size_t)(NT - 1) * 64 * PITCH), vreg = *(const v4u*)(vsrc + (size_t)(NT - 1) * 64 * PITCH);
    float mrun = -INFINITY, lrun = 0.f; f32x16 o0, o1;
#pragma unroll
    for (int r = 0; r < 16; ++r) { o0[r] = 0.f; o1[r] = 0.f; }
    const int vbl = ((lane >> 4) & 1) * 32 + (lane & 3) * 8 + (4 * hi + ((lane & 15) >> 2)) * 64;
    int it = 0;
    for (int t = NT - 1; t >= 0; --t, ++it) {
        const int slot = (it & 1) * 8192;
        *(LAS v4u*)(lds + L_K + slot + stg) = kreg; *(LAS v4u*)(lds + L_V + slot + stg) = vreg;
        __syncthreads();
        if (it > 0) { const LAS int* mf = MM + ((it - 1) & 1) * 8; const int allf = mf[0] & mf[1] & mf[2] & mf[3] & mf[4] & mf[5] & mf[6] & mf[7]; if (allf) break; }
        if (t > 0) { kreg = *(const v4u*)(ksrc + (size_t)(t - 1) * 64 * PITCH); vreg = *(const v4u*)(vsrc + (size_t)(t - 1) * 64 * PITCH); }
        if (t <= wtop) {
            f32x16 p0, p1;
#pragma unroll
            for (int r = 0; r < 16; ++r) { p0[r] = 0.f; p1[r] = 0.f; }
            const LAS unsigned char* kb = lds + L_K + slot + hi * 1024 + r32 * 16;
#pragma unroll
            for (int d0 = 0; d0 < 4; ++d0) {
                const bf16x8 b0 = *(const LAS bf16x8*)(kb + d0 * 2048), b1 = *(const LAS bf16x8*)(kb + d0 * 2048 + 512);
                p0 = __builtin_amdgcn_mfma_f32_32x32x16_bf16(b0, qr[d0], p0, 0, 0, 0);
                p1 = __builtin_amdgcn_mfma_f32_32x32x16_bf16(b1, qr[d0], p1, 0, 0, 0);
            }
            const LAS float* nbt = nb + t * 64 + 4 * hi;
#pragma unroll
            for (int g = 0; g < 4; ++g) { const f32x4 n0 = *(const LAS f32x4*)(nbt + 8 * g), n1 = *(const LAS f32x4*)(nbt + 32 + 8 * g);
#pragma unroll
                for (int e = 0; e < 4; ++e) { p0[4 * g + e] = p0[4 * g + e] * C2 + n0[e]; p1[4 * g + e] = p1[4 * g + e] * C2 + n1[e]; } }
            if (t * 64 + 63 > q0 + wid * 32) {
#pragma unroll
                for (int r = 0; r < 16; ++r) { const int kv = t * 64 + crow(r, hi); if (kv > qrow) p0[r] = -INFINITY; if (kv + 32 > qrow) p1[r] = -INFINITY; }
            }
            float rm = -INFINITY;
#pragma unroll
            for (int r = 0; r < 16; ++r) rm = fmaxf(rm, fmaxf(p0[r], p1[r]));
            rm = fmaxf(rm, __shfl_xor(rm, 32));
            if (__any(rm > mrun + 8.0f)) {
                const float mnew = fmaxf(mrun, rm);
                const float alpha = __builtin_amdgcn_exp2f(mrun - mnew);
                mrun = mnew; lrun *= alpha;
                if (hi == 0) al[r32] = alpha;
                asm volatile("s_waitcnt lgkmcnt(0)" ::: "memory");
#pragma unroll
                for (int g = 0; g < 4; ++g) { const f32x4 a4 = *(const LAS f32x4*)(al + 8 * g + 4 * hi);
#pragma unroll
                    for (int e = 0; e < 4; ++e) { o0[4 * g + e] *= a4[e]; o1[4 * g + e] *= a4[e]; } }
            }
            float sum = 0.f;
#pragma unroll
            for (int r = 0; r < 16; ++r) { p0[r] = __builtin_amdgcn_exp2f(p0[r] - mrun); p1[r] = __builtin_amdgcn_exp2f(p1[r] - mrun); sum += p0[r] + p1[r]; }
            lrun += sum;
            bf16x8 pa[4];
#pragma unroll
            for (int k = 0; k < 2; ++k) {
                v4u w0, w1;
                w0.x = cvtpk(p0[8 * k + 0], p0[8 * k + 1]); w0.y = cvtpk(p0[8 * k + 2], p0[8 * k + 3]); w0.z = cvtpk(p0[8 * k + 4], p0[8 * k + 5]); w0.w = cvtpk(p0[8 * k + 6], p0[8 * k + 7]);
                w1.x = cvtpk(p1[8 * k + 0], p1[8 * k + 1]); w1.y = cvtpk(p1[8 * k + 2], p1[8 * k + 3]); w1.z = cvtpk(p1[8 * k + 4], p1[8 * k + 5]); w1.w = cvtpk(p1[8 * k + 6], p1[8 * k + 7]);
                pa[k] = __builtin_bit_cast(bf16x8, w0); pa[2 + k] = __builtin_bit_cast(bf16x8, w1);
            }
            const unsigned vb = (unsigned)(size_t)(lds + L_V + slot) + vbl;
#pragma unroll
            for (int d0 = 0; d0 < 2; ++d0) {
                s16x4 lo[4], hh[4];
#pragma unroll
                for (int ks = 0; ks < 4; ++ks) {
                    asm volatile("ds_read_b64_tr_b16 %0, %1 offset:%c2" : "=&v"(lo[ks]) : "v"(vb), "i"(d0 * 4096 + ks * 1024) : "memory");
                    asm volatile("ds_read_b64_tr_b16 %0, %1 offset:%c2" : "=&v"(hh[ks]) : "v"(vb), "i"(d0 * 4096 + ks * 1024 + 512) : "memory");
                }
                asm volatile("s_waitcnt lgkmcnt(0)" ::: "memory"); __builtin_amdgcn_sched_barrier(0);
#pragma unroll
                for (int ks = 0; ks < 4; ++ks) {
                    const bf16x8 vf = (bf16x8){lo[ks][0], lo[ks][1], lo[ks][2], lo[ks][3], hh[ks][0], hh[ks][1], hh[ks][2], hh[ks][3]};
                    if (d0 == 0) o0 = __builtin_amdgcn_mfma_f32_32x32x16_bf16(pa[ks], vf, o0, 0, 0, 0); else o1 = __builtin_amdgcn_mfma_f32_32x32x16_bf16(pa[ks], vf, o1, 0, 0, 0);
                }
            }
        }
        { const bool done = (t > 0) && (nb[t * 64 - 1] + qkb <= mrun); const int fl = __all(done) ? 1 : 0; if (lane == 0) MM[(it & 1) * 8 + wid] = fl; }
    }
    lrun += __shfl_xor(lrun, 32);
    if (hi == 0) al[r32] = 1.f / lrun;
    asm volatile("s_waitcnt lgkmcnt(0)" ::: "memory");
    bf16* Ow = OMIX + (rowbase + q0 + wid * 32) * DM + 512 + h * 64;
#pragma unroll
    for (int r = 0; r < 16; ++r) { const int orow = crow(r, hi); const float il = al[orow];
        Ow[(size_t)orow * DM + r32] = (bf16)f2bf(o0[r] * il); Ow[(size_t)orow * DM + 32 + r32] = (bf16)f2bf(o1[r] * il); }
    __syncthreads();
}
__device__ __forceinline__ void phase(LAS unsigned char* lds, const bf16* PE, const float* F, const float* KMAX, bf16* OMIX) {
    const int bx = blockIdx.x, G = gridDim.x; const int vcu = (G % 8 == 0) ? (bx % 8) * (G / 8) + bx / 8 : bx;
    for (int v = vcu; v < 256; v += G) {
        const int bh = v >> 2, sub = v & 3;
#pragma unroll 1
        for (int i = 0; i < 4; ++i) { const int qb = (i == 0) ? sub : (i == 1) ? 7 - sub : (i == 2) ? 8 + sub : 15 - sub; attn_unit(bh >> 3, bh & 7, qb, PE, F, KMAX, OMIX, lds); }
    }
}
__device__ __forceinline__ void scan_phase(LAS unsigned char* lds, const float* TE, const float* bfv, const bf16* PE, float* F, float* KMAX) {
    const int lane = threadIdx.x & 63, wid = threadIdx.x >> 6;
    LAS float* red = (LAS float*)lds;
    const bool spread = gridDim.x == 256;
    const int bh0 = spread ? (((int)blockIdx.x & 3) == 0 ? (int)blockIdx.x >> 2 : 64) : (int)blockIdx.x, bhs = spread ? 64 : (int)gridDim.x;
    for (int bh = bh0; bh < 64; bh += bhs) {
        const int b = bh >> 3, h = bh & 7;
        {
            const float bb = bfv[h]; const int tid = threadIdx.x;
            float v[8];
#pragma unroll
            for (int i = 0; i < 8; ++i) v[i] = TE[((size_t)b * SEQ + tid * 8 + i) * 32 + 16 + h];
            float run = 0.f;
#pragma unroll
            for (int i = 0; i < 8; ++i) { run += log_sigmoid(v[i] + bb); v[i] = run; }
            float inc = run;
#pragma unroll
            for (int o = 1; o < 64; o <<= 1) { const float y = __shfl_up(inc, o); if (lane >= o) inc += y; }
            if (lane == 63) red[16 + wid] = inc;
            __syncthreads();
            float pre = inc - run;
            for (int w = 0; w < wid; ++w) pre += red[16 + w];
            f32x4* fo = (f32x4*)(F + (size_t)bh * SEQ + tid * 8);
            fo[0] = (f32x4){v[0] + pre, v[1] + pre, v[2] + pre, v[3] + pre}; fo[1] = (f32x4){v[4] + pre, v[5] + pre, v[6] + pre, v[7] + pre};
        }
        float mx = 0.f;
        for (int r = 0; r < 8; ++r) { const bf16* kr = PE + ((size_t)b * SEQ + wid * 512 + r * 64 + lane) * PITCH + 2048 + h * 64; float s2 = 0.f;
#pragma unroll
            for (int c = 0; c < 8; ++c) { const v4u kv = *(const v4u*)(kr + c * 8);
#pragma unroll
                for (int e = 0; e < 4; ++e) { const float k0 = __builtin_bit_cast(float, kv[e] << 16), k1 = __builtin_bit_cast(float, kv[e] & 0xffff0000u); s2 += k0 * k0 + k1 * k1; } }
            mx = fmaxf(mx, s2); }
        mx = wave_max(mx);
        if (lane == 0) red[wid] = mx;
        __syncthreads();
        if (threadIdx.x == 0) KMAX[bh] = fmaxf(fmaxf(fmaxf(red[0], red[1]), fmaxf(red[2], red[3])), fmaxf(fmaxf(red[4], red[5]), fmaxf(red[6], red[7])));
        __syncthreads();
    }
}
}
namespace gla {
typedef short bf16x8 __attribute__((ext_vector_type(8)));
typedef short s16x4 __attribute__((ext_vector_type(4)));
typedef float f32x16 __attribute__((ext_vector_type(16)));
typedef float f32x2 __attribute__((ext_vector_type(2)));
constexpr int L_GS = 0, L_SEG = 16384, L_KD = 18432, L_QD = 26624, L_V = 34816, L_S = 51200, L_SSQ = 67584, L_WG = 68608, L_GATE = 73216, GPITCH = 272, LDS_BYTES = L_GATE + 2 * 64 * GPITCH;
__device__ __forceinline__ int crow(int r, int hi) { return (r & 3) + 8 * (r >> 2) + 4 * hi; }
__device__ __forceinline__ s16x4 trq(unsigned addr) { s16x4 r; asm volatile("ds_read_b64_tr_b16 %0, %1" : "=&v"(r) : "v"(addr) : "memory"); return r; }
#define GLA_LDS_WAIT() do { asm volatile("s_waitcnt lgkmcnt(0)" ::: "memory"); __builtin_amdgcn_sched_barrier(0); } while (0)
__device__ __forceinline__ bf16x8 cat(s16x4 a, s16x4 b) { return (bf16x8){a[0], a[1], a[2], a[3], b[0], b[1], b[2], b[3]}; }
__device__ __forceinline__ unsigned cvtpk(float lo, float hi) { return pg8::cvt_pk_bf16(lo, hi); }
__device__ __forceinline__ float bfe(const v4u& v, int e) { return __builtin_bit_cast(float, (e & 1) ? (v[e >> 1] & 0xffff0000u) : (v[e >> 1] << 16)); }
__device__ __forceinline__ int tr_off(int row, int col) { return ((col >> 5) * 4 + (row >> 4)) * 1024 + (row & 15) * 64 + ((col >> 3) & 3) * 16; }

struct In1 { f32x4 te[4]; v4u k, v0, v1; };
struct In3 { f32x4 ga, gb; v4u q, k, v0, v1, s0, s1, g0, g1; };
__device__ __forceinline__ void chunk_ids(int ch, int& b, int& h, size_t& m0) { const int bh = ch >> 6, n = ch & 63; b = bh >> 2; h = bh & 3; m0 = (size_t)b * SEQ + n * 64; }
__device__ __forceinline__ void load_in1(In1& I, const bf16* PE, const float* TE, int ch) {
    int b, h; size_t m0; chunk_ids(ch, b, h, m0);
    const int t = threadIdx.x >> 3, dg = threadIdx.x & 7; const f32x4* te = (const f32x4*)(TE + (m0 + t) * 32); const bf16* pe = PE + (m0 + t) * NE_BF;
#pragma unroll
    for (int j = 0; j < 4; ++j) I.te[j] = te[j];
    I.k = *(const v4u*)(pe + 256 + h * 64 + dg * 8); I.v0 = *(const v4u*)(pe + 512 + h * 128 + dg * 16); I.v1 = *(const v4u*)(pe + 512 + h * 128 + dg * 16 + 8);
}
__device__ __forceinline__ void load_in3(In3& I, const bf16* PE, const bf16* OMIX, const bf16* SP, int ch) {
    int b, h; size_t m0; chunk_ids(ch, b, h, m0);
    const int t = threadIdx.x >> 3, dg = threadIdx.x & 7; const bf16* pe = PE + (m0 + t) * NE_BF;
    { const f32x4* gp = (const f32x4*)(OMIX + (m0 + t) * DM + h * 128) + dg * 2; I.ga = gp[0]; I.gb = gp[1]; }
    I.q = *(const v4u*)(pe + h * 64 + dg * 8); I.k = *(const v4u*)(pe + 256 + h * 64 + dg * 8);
    I.v0 = *(const v4u*)(pe + 512 + h * 128 + dg * 16); I.v1 = *(const v4u*)(pe + 512 + h * 128 + dg * 16 + 8);
    I.g0 = *(const v4u*)(pe + 1024 + h * 128 + dg * 16); I.g1 = *(const v4u*)(pe + 1024 + h * 128 + dg * 16 + 8);
    const bf16* sp = SP + ((size_t)ch * 64 + t) * 128 + dg * 16; I.s0 = *(const v4u*)sp; I.s1 = *(const v4u*)(sp + 8);
}
__device__ __forceinline__ void load_wg(LAS unsigned char* lds, const float* Wg, const float* bg, int h) {
    LAS float* W = (LAS float*)(lds + L_WG);
    for (int i = threadIdx.x; i < 17 * 64; i += 512) { const int r = i >> 6, d = i & 63; W[i] = r < 16 ? Wg[r * 256 + h * 64 + d] : bg[h * 64 + d]; }
    __syncthreads();
}
__device__ __forceinline__ void gates(LAS unsigned char* lds, const f32x4 (&te)[4]) {
    const int tid = threadIdx.x;
    LAS float* GS = (LAS float*)(lds + L_GS); LAS float* SEG = (LAS float*)(lds + L_SEG); const LAS float* W = (const LAS float*)(lds + L_WG);
    { const int t = tid >> 3, dg = tid & 7;
        const LAS f32x4* wb = (const LAS f32x4*)(W + 16 * 64 + dg * 8);
        f32x4 x0 = wb[0], x1 = wb[1];
#pragma unroll
        for (int r = 0; r < 16; ++r) { const float tv = te[r >> 2][r & 3]; const LAS f32x4* wr = (const LAS f32x4*)(W + r * 64 + dg * 8); x0 += wr[0] * tv; x1 += wr[1] * tv; }
        f32x4 g0, g1;
#pragma unroll
        for (int e = 0; e < 4; ++e) { g0[e] = log_sigmoid(x0[e]) * (1.f / 16.f); g1[e] = log_sigmoid(x1[e]) * (1.f / 16.f); }
        *(LAS f32x4*)(GS + t * 64 + dg * 8) = g0; *(LAS f32x4*)(GS + t * 64 + dg * 8 + 4) = g1; }
    __syncthreads();
    { const int d = tid & 63, seg = tid >> 6; float run = 0.f;
#pragma unroll
        for (int i = 0; i < 8; ++i) { run += GS[(seg * 8 + i) * 64 + d]; GS[(seg * 8 + i) * 64 + d] = run; }
        SEG[seg * 64 + d] = run;
        __syncthreads();
        float pre = 0.f;
        for (int s = 0; s < seg; ++s) pre += SEG[s * 64 + d];
#pragma unroll
        for (int i = 0; i < 8; ++i) GS[(seg * 8 + i) * 64 + d] += pre; }
    __syncthreads();
}
__device__ __forceinline__ void g1_phase(LAS unsigned char* lds, const bf16* PE, const float* TE, const float* Wg, const float* bg, float* U, float* DEC, bf16* OMIX) {
    const int tid = threadIdx.x, lane = tid & 63, r32 = lane & 31, hi = lane >> 5; const int wid = __builtin_amdgcn_readfirstlane(tid >> 6);
    LAS float* GS = (LAS float*)(lds + L_GS); LAS float* SEG = (LAS float*)(lds + L_SEG);
    if ((int)blockIdx.x >= 2048) return;
    int hcur = -1;
    const bool spread = gridDim.x == 256;
    const int bi = (int)blockIdx.x & 63, hg = (int)blockIdx.x >> 6;
    const bool scanwg = (bi & 3) == 0;
    const int nit = spread ? (scanwg ? 2 : 10) : (2048 - (int)blockIdx.x + (int)gridDim.x - 1) / (int)gridDim.x;
    const int qa = scanwg ? 480 + (bi >> 2) : bi - (bi >> 2) - 1, qs = scanwg ? 16 : 48;
#define G1_CH(k) (spread ? 256 * ((qa + qs * (k)) >> 6) + 64 * hg + ((qa + qs * (k)) & 63) : (int)blockIdx.x + (int)gridDim.x * (k))
    In1 I; load_in1(I, PE, TE, G1_CH(0));
    for (int kk = 0; kk < nit; ++kk) { const int ch = G1_CH(kk);
        { const int hh = (ch >> 6) & 3; if (hh != hcur) { __syncthreads(); load_wg(lds, Wg, bg, hh); hcur = hh; } }
        gates(lds, I.te);
        { const int t = tid >> 3, dg = tid & 7;
            { int b_, h_; size_t m0_; chunk_ids(ch, b_, h_, m0_);
                f32x4* gp = (f32x4*)(OMIX + (m0_ + t) * DM + h_ * 128) + dg * 2; gp[0] = *(const LAS f32x4*)(GS + t * 64 + dg * 8); gp[1] = *(const LAS f32x4*)(GS + t * 64 + dg * 8 + 4); }
            float ke[8];
#pragma unroll
            for (int e = 0; e < 8; ++e) { const int d = dg * 8 + e; const float gl = GS[63 * 64 + d];
                ke[e] = bfe(I.k, e) * exp_hw(gl - GS[t * 64 + d]); }
            v4u o; o.x = cvtpk(ke[0], ke[1]); o.y = cvtpk(ke[2], ke[3]); o.z = cvtpk(ke[4], ke[5]); o.w = cvtpk(ke[6], ke[7]);
            *(LAS v4u*)(lds + L_KD + tr_off(t, dg * 8)) = o;
            *(LAS v4u*)(lds + L_V + tr_off(t, dg * 16)) = I.v0; *(LAS v4u*)(lds + L_V + tr_off(t, dg * 16 + 8)) = I.v1; }
        if (tid < 64) DEC[(size_t)ch * 64 + tid] = exp_hw(GS[63 * 64 + tid]);
        __syncthreads();
        if (kk + 1 < nit) load_in1(I, PE, TE, G1_CH(kk + 1));
        { const int mt = wid & 1, nt = wid >> 1; const int q = (lane & 15) >> 2, p = lane & 3, blk = (lane >> 4) & 1;
            const unsigned lb = (unsigned)(size_t)lds, ro = (8 * hi + q) * 64 + blk * 32 + p * 8;
            s16x4 fa[4][2], fb[4][2];
#pragma unroll
            for (int ks = 0; ks < 4; ++ks) { const unsigned aa = lb + L_KD + (mt * 4 + ks) * 1024 + ro, ba = lb + L_V + (nt * 4 + ks) * 1024 + ro;
                fa[ks][0] = trq(aa); fa[ks][1] = trq(aa + 256); fb[ks][0] = trq(ba); fb[ks][1] = trq(ba + 256); }
            GLA_LDS_WAIT();
            f32x16 acc;
#pragma unroll
            for (int r = 0; r < 16; ++r) acc[r] = 0.f;
#pragma unroll
            for (int ks = 0; ks < 4; ++ks) acc = __builtin_amdgcn_mfma_f32_32x32x16_bf16(cat(fa[ks][0], fa[ks][1]), cat(fb[ks][0], fb[ks][1]), acc, 0, 0, 0);
            float* Uo = U + (size_t)ch * 8192 + nt * 32 + r32;
#pragma unroll
            for (int r = 0; r < 16; ++r) Uo[(size_t)(mt * 32 + crow(r, hi)) * 128] = acc[r]; }
    }
#undef G1_CH
}
__device__ __forceinline__ void g2_phase(const float* U, const float* DEC, bf16* SP) {
    for (int gid = blockIdx.x * 512 + threadIdx.x; gid < 131072; gid += gridDim.x * 512) {
        const int bh = gid >> 12, d = (gid >> 6) & 63, v2 = gid & 63;
        f32x2 S = {0.f, 0.f};
#pragma unroll 32
        for (int n = 0; n < 64; ++n) { const size_t ch = (size_t)bh * 64 + n; const size_t off = (ch * 64 + d) * 128 + 2 * v2;
            const f32x2 u = *(const f32x2*)(U + off); const float dc = DEC[ch * 64 + d];
            *(unsigned*)(SP + off) = pk2(S.x, S.y);
            S = S * dc + u; }
    }
}
__device__ __forceinline__ void g3_phase(LAS unsigned char* lds, const bf16* PE, const float* TE, const float* Wg, const float* bg, const bf16* SP, const float* gn, bf16* OMIX) {
    const int tid = threadIdx.x, lane = tid & 63, r32 = lane & 31, hi = lane >> 5; const int wid = __builtin_amdgcn_readfirstlane(tid >> 6);
    LAS float* GS = (LAS float*)(lds + L_GS); LAS float* SSQ = (LAS float*)(lds + L_SSQ);
    if ((int)blockIdx.x >= 2048) return;
    In3 I; load_in3(I, PE, OMIX, SP, blockIdx.x);
    int gpar = 0;
    for (int ch = blockIdx.x; ch < 2048; ch += gridDim.x) {
        int b, h; size_t m0; chunk_ids(ch, b, h, m0);
        const int lgate = L_GATE + (gpar ? 64 * GPITCH : 0); gpar ^= 1;
        { const int t = tid >> 3, dg = tid & 7;
            const f32x4 ga = I.ga, gb = I.gb;
            float qd[8], kd[8];
#pragma unroll
            for (int e = 0; e < 8; ++e) { const float g = e < 4 ? ga[e & 3] : gb[e & 3]; qd[e] = bfe(I.q, e) * 0.125f * exp_hw(g); kd[e] = bfe(I.k, e) * exp_hw(-g); }
            v4u o; o.x = cvtpk(qd[0], qd[1]); o.y = cvtpk(qd[2], qd[3]); o.z = cvtpk(qd[4], qd[5]); o.w = cvtpk(qd[6], qd[7]);
            *(LAS v4u*)(lds + L_QD + dg * 1024 + t * 16) = o;
            o.x = cvtpk(kd[0], kd[1]); o.y = cvtpk(kd[2], kd[3]); o.z = cvtpk(kd[4], kd[5]); o.w = cvtpk(kd[6], kd[7]);
            *(LAS v4u*)(lds + L_KD + dg * 1024 + t * 16) = o;
            *(LAS v4u*)(lds + L_V + tr_off(t, dg * 16)) = I.v0; *(LAS v4u*)(lds + L_V + tr_off(t, dg * 16 + 8)) = I.v1;
            *(LAS v4u*)(lds + L_S + tr_off(t, dg * 16)) = I.s0; *(LAS v4u*)(lds + L_S + tr_off(t, dg * 16 + 8)) = I.s1;
            *(LAS v4u*)(lds + lgate + t * GPITCH + dg * 32) = I.g0; *(LAS v4u*)(lds + lgate + t * GPITCH + dg * 32 + 16) = I.g1; }
        __syncthreads();
        if (ch + (int)gridDim.x < 2048) load_in3(I, PE, OMIX, SP, ch + gridDim.x);
        const int it = wid & 1, nt = wid >> 1; const int q = (lane & 15) >> 2, p = lane & 3, blk = (lane >> 4) & 1;
        const unsigned lb = (unsigned)(size_t)lds;
        f32x16 acc;
#pragma unroll
        for (int r = 0; r < 16; ++r) acc[r] = 0.f;
        { bf16x8 af[4]; s16x4 sb[4][2];
#pragma unroll
            for (int ks = 0; ks < 4; ++ks) { af[ks] = *(const LAS bf16x8*)(lds + L_QD + (2 * ks + hi) * 1024 + (32 * it + r32) * 16);
                const unsigned ba = lb + L_S + (nt * 4 + ks) * 1024 + (8 * hi + q) * 64 + blk * 32 + p * 8; sb[ks][0] = trq(ba); sb[ks][1] = trq(ba + 256); }
            GLA_LDS_WAIT();
#pragma unroll
            for (int ks = 0; ks < 4; ++ks) acc = __builtin_amdgcn_mfma_f32_32x32x16_bf16(af[ks], cat(sb[ks][0], sb[ks][1]), acc, 0, 0, 0); }
        for (int jt = 0; jt <= it; ++jt) {
            bf16x8 kf[4], qf[4]; s16x4 vv[2][2];
#pragma unroll
            for (int ks = 0; ks < 4; ++ks) { kf[ks] = *(const LAS bf16x8*)(lds + L_KD + (2 * ks + hi) * 1024 + (32 * jt + r32) * 16); qf[ks] = *(const LAS bf16x8*)(lds + L_QD + (2 * ks + hi) * 1024 + (32 * it + r32) * 16); }
#pragma unroll
            for (int s = 0; s < 2; ++s) { const unsigned va = lb + L_V + (nt * 4 + 2 * jt + s) * 1024 + (4 * hi + q) * 64 + blk * 32 + p * 8; vv[s][0] = trq(va); vv[s][1] = trq(va + 512); }
            GLA_LDS_WAIT();
            f32x16 X;
#pragma unroll
            for (int r = 0; r < 16; ++r) X[r] = 0.f;
#pragma unroll
            for (int ks = 0; ks < 4; ++ks) X = __builtin_amdgcn_mfma_f32_32x32x16_bf16(kf[ks], qf[ks], X, 0, 0, 0);
            if (jt == it) {
#pragma unroll
                for (int r = 0; r < 16; ++r) if (crow(r, hi) > r32) X[r] = 0.f;
            }
#pragma unroll
            for (int s = 0; s < 2; ++s) {
                v4u w; w.x = cvtpk(X[8 * s + 0], X[8 * s + 1]); w.y = cvtpk(X[8 * s + 2], X[8 * s + 3]); w.z = cvtpk(X[8 * s + 4], X[8 * s + 5]); w.w = cvtpk(X[8 * s + 6], X[8 * s + 7]);
                acc = __builtin_amdgcn_mfma_f32_32x32x16_bf16(__builtin_bit_cast(bf16x8, w), cat(vv[s][0], vv[s][1]), acc, 0, 0, 0);
            }
        }
#pragma unroll
        for (int r = 0; r < 16; ++r) { float s = acc[r] * acc[r];
            s += __shfl_xor(s, 1); s += __shfl_xor(s, 2); s += __shfl_xor(s, 4); s += __shfl_xor(s, 8); s += __shfl_xor(s, 16);
            if (r32 == 0) SSQ[(32 * it + crow(r, hi)) * 4 + nt] = s; }
        __syncthreads();
        { const int v = nt * 32 + r32; const float gnv = gn[v];
#pragma unroll
            for (int r = 0; r < 16; ++r) { const int i = 32 * it + crow(r, hi); const f32x4 sq = *(const LAS f32x4*)(SSQ + i * 4);
                const float rstd = rsqrtf(((sq.x + sq.y) + (sq.z + sq.w)) * (1.f / 128.f) + EPS);
                LAS unsigned short* gp = (LAS unsigned short*)(lds + lgate + i * GPITCH) + v;
                const float g = bf2f(*gp);
                *gp = (unsigned short)f2bf(acc[r] * rstd * gnv * (g * __builtin_amdgcn_rcpf(1.f + __builtin_amdgcn_exp2f(-1.4426950408889634f * g)))); } }
        __syncthreads();
        { const int t = tid >> 3, dg = tid & 7; const v4u o0 = *(const LAS v4u*)(lds + lgate + t * GPITCH + dg * 32), o1 = *(const LAS v4u*)(lds + lgate + t * GPITCH + dg * 32 + 16);
            bf16* op = OMIX + (m0 + t) * DM + h * 128 + dg * 16; *(v4u*)op = o0; *(v4u*)(op + 8) = o1; }
    }
}
}
namespace dsa {
typedef short bf16x8 __attribute__((ext_vector_type(8)));
typedef short s16x4 __attribute__((ext_vector_type(4)));
constexpr float L2E = 1.4426950408889634f;
constexpr int PIECE = 1056, CHUNK_BYTES = 16 * PIECE;
constexpr int NBIN = 256;
constexpr int W_ROW = 8192, W_CAND = 16384, W_HIST = CHUNK_BYTES, W_LIST = W_HIST + 1056, WAVE_LDS = W_LIST + 2048;
constexpr int L_WAVE = 0, L_T5 = 8 * WAVE_LDS, L_LUT = L_T5 + 2048 + 64, L_MM = L_LUT + 128, LDS_BYTES = L_MM + 1024;
constexpr size_t SCR_QL = 0, SCR_OL = 262144, SCR_BYTES = 524288;
__device__ __forceinline__ bf16x8 cat(s16x4 a, s16x4 b) { return (bf16x8){a[0], a[1], a[2], a[3], b[0], b[1], b[2], b[3]}; }
__device__ __forceinline__ float relu_bits(float x) { const int b = __builtin_bit_cast(int, x); return __builtin_bit_cast(float, b > 0 ? b : 0); }
__device__ __forceinline__ int wave_isum(int v) {
#pragma unroll
    for (int o = 1; o < 64; o <<= 1) v += __shfl_xor(v, o);
    return v;
}
__device__ __forceinline__ int mbcnt64(unsigned long long m) { return __builtin_amdgcn_mbcnt_hi((unsigned)(m >> 32), __builtin_amdgcn_mbcnt_lo((unsigned)m, 0u)); }

__device__ __forceinline__ int bin_of(float x, float nls, float scale) { int b = (int)__builtin_fmaf(x, scale, nls); b = b < 0 ? 0 : b; return b > NBIN - 1 ? NBIN - 1 : b; }
typedef _Float16 f16x4 __attribute__((ext_vector_type(4)));
__device__ __forceinline__ f32x4 ldrow_full(const LAS unsigned char* rowp, int J, int lane) {
    const f16x4 hv = *(const LAS f16x4*)(rowp + 2 * (256 * J + 4 * lane));
    return __builtin_convertvector(hv, f32x4);
}
__device__ __forceinline__ f32x4 ldrow(const LAS unsigned char* rowp, int J, int lane, int t) {
    const int s0 = 256 * J + 4 * lane;
    const f16x4 hv = *(const LAS f16x4*)(rowp + 2 * s0);
    f32x4 x = __builtin_convertvector(hv, f32x4);
#pragma unroll
    for (int e = 0; e < 4; ++e) x[e] = s0 + e <= t ? x[e] : -INFINITY;
    return x;
}
constexpr int CAND_CAP = 384;
static_assert(W_CAND + 4 * CAND_CAP <= W_LIST, "candidate array");
__device__ __forceinline__ unsigned cand_pack(float x, int s) {
    unsigned hb = (unsigned)__builtin_bit_cast(unsigned short, (_Float16)x);
    hb = hb == 0x8000u ? 0u : hb;
    const unsigned k = (hb & 0x8000u) ? (~hb & 0xffffu) : (hb | 0x8000u);
    return (k << 16) | (unsigned)(0xffff - s);
}
__device__ __forceinline__ int enc_key(int s, int t, const LAS unsigned char* lut) { const int d = t - s; return (s << 8) | (d < 128 ? (int)lut[d] : 31); }
constexpr int LIST_EMPTY = 32;
__device__ __forceinline__ void enc_list(LAS int* list, int t, const LAS unsigned char* lut, int lane) {
    int s[4];
#pragma unroll
    for (int j = 0; j < 4; ++j) s[j] = list[lane + 64 * j];
#pragma unroll
    for (int j = 0; j < 4; ++j) s[j] = enc_key(s[j], t, lut);
#pragma unroll
    for (int j = 0; j < 4; ++j) list[lane + 64 * j] = s[j];
}
__device__ __forceinline__ int select_row(const LAS unsigned char* rowp, int t, float lo, float hi, LAS int* list, LAS unsigned* hist, LAS unsigned* candp, const LAS unsigned char* lut, int lane) {
    const int n = t + 1;
    if (n <= 256) {
#pragma unroll
        for (int j = 0; j < 4; ++j) { const int s = lane + 64 * j; list[s] = s <= t ? enc_key(s, t, lut) : LIST_EMPTY; }
        return n;
    }
    const int nJ = (t >> 8) + 1;
    const float scale = hi > lo ? (float)(NBIN - 1) / (hi - lo) : 0.f;
    const float nls = -lo * scale;
#pragma unroll
    for (int j = 0; j < NBIN / 64; ++j) hist[lane + 64 * j] = 0u;
#pragma unroll 2
    for (int J = 0; J < nJ - 1; ++J) { const f32x4 x = ldrow_full(rowp, J, lane);
#pragma unroll
        for (int e = 0; e < 4; ++e) __hip_atomic_fetch_add(hist + bin_of(x[e], nls, scale), 1u, __ATOMIC_RELAXED, __HIP_MEMORY_SCOPE_WORKGROUP); }
    { const f32x4 x = ldrow(rowp, nJ - 1, lane, t);
#pragma unroll
        for (int e = 0; e < 4; ++e) if (x[e] != -INFINITY) __hip_atomic_fetch_add(hist + bin_of(x[e], nls, scale), 1u, __ATOMIC_RELAXED, __HIP_MEMORY_SCOPE_WORKGROUP); }
    const v4u h4 = *(const LAS v4u*)(hist + 4 * lane);
    const int cl = (int)(h4.x + h4.y + h4.z + h4.w);
    int suf = cl;
#pragma unroll
    for (int o = 1; o < 64; o <<= 1) { const int y = __shfl_down(suf, o); if (lane + o < 64) suf += y; }
    const unsigned long long bal = __ballot(suf >= 256);
    const int Lt = 63 - __builtin_clzll(bal);
    int Tb, above;
    { int cum = suf - cl;
        if (cum + (int)h4.w >= 256) { Tb = 4 * lane + 3; above = cum; }
        else { cum += (int)h4.w; if (cum + (int)h4.z >= 256) { Tb = 4 * lane + 2; above = cum; }
        else { cum += (int)h4.z; if (cum + (int)h4.y >= 256) { Tb = 4 * lane + 1; above = cum; }
        else { cum += (int)h4.y; Tb = 4 * lane; above = cum; } } } }
    Tb = __shfl(Tb, Lt); above = __shfl(above, Lt);
    const int r = 256 - above;
    int base = 0, ccount = 0;
#pragma unroll 2
    for (int J = 0; J < nJ; ++J) { const bool lastg = J == nJ - 1; const f32x4 x = lastg ? ldrow(rowp, J, lane, t) : ldrow_full(rowp, J, lane);
        int bb[4]; const int s0 = 256 * J + 4 * lane;
#pragma unroll
        for (int e = 0; e < 4; ++e) { bb[e] = bin_of(x[e], nls, scale); if (lastg) bb[e] = x[e] != -INFINITY ? bb[e] : -1; }
#pragma unroll
        for (int e = 0; e < 4; ++e) { const unsigned long long gm = __ballot(bb[e] > Tb);
            if (bb[e] > Tb) list[base + mbcnt64(gm)] = s0 + e;
            base += __builtin_popcountll(gm); }
        if (__any(bb[0] == Tb || bb[1] == Tb || bb[2] == Tb || bb[3] == Tb)) {
#pragma unroll
            for (int e = 0; e < 4; ++e) { const unsigned long long cm = __ballot(bb[e] == Tb);
                const int p = ccount + mbcnt64(cm); if (bb[e] == Tb && p < CAND_CAP) candp[p] = cand_pack(x[e], s0 + e); ccount += __builtin_popcountll(cm); } } }
    if (ccount <= 64) {
        const unsigned xk = lane < ccount ? candp[lane] : 0u;
        int rank = 0;
#pragma unroll 4
        for (int j = 0; j < ccount; ++j) rank += candp[j] > xk ? 1 : 0;
        const bool sel = lane < ccount && rank < r;
        const unsigned long long sm = __ballot(sel);
        if (sel) list[above + mbcnt64(sm)] = 0xffff - (int)(xk & 0xffffu);
        enc_list(list, t, lut, lane);
        return 256;
    }
    if (ccount <= CAND_CAP) {
        unsigned xk[CAND_CAP / 64]; int rank[CAND_CAP / 64];
#pragma unroll
        for (int q = 0; q < CAND_CAP / 64; ++q) { xk[q] = lane + 64 * q < ccount ? candp[lane + 64 * q] : 0u; rank[q] = 0; }
#pragma unroll 2
        for (int j = 0; j < ccount; ++j) { const unsigned y = candp[j];
#pragma unroll
            for (int q = 0; q < CAND_CAP / 64; ++q) rank[q] += y > xk[q] ? 1 : 0; }
        int off = above;
#pragma unroll
        for (int q = 0; q < CAND_CAP / 64; ++q) { const bool sel = lane + 64 * q < ccount && rank[q] < r; const unsigned long long sm = __ballot(sel);
            if (sel) list[off + mbcnt64(sm)] = 0xffff - (int)(xk[q] & 0xffffu);
            off += __builtin_popcountll(sm); }
        enc_list(list, t, lut, lane);
        return 256;
    }
    float tau; int cgt;
    { unsigned key = 0u;
        for (int bit = 31; bit >= 0; --bit) {
            const unsigned cnd = key | (1u << bit); int c = 0;
            for (int J = 0; J < nJ; ++J) { const f32x4 x = ldrow(rowp, J, lane, t);
#pragma unroll
                for (int e = 0; e < 4; ++e) if (x[e] != -INFINITY) c += (bin_of(x[e], nls, scale) == Tb && ord_key(x[e]) >= cnd) ? 1 : 0; }
            if (wave_isum(c) >= r) key = cnd;
        }
        const unsigned ub = (key & 0x80000000u) ? (key & 0x7fffffffu) : ~key;
        tau = __builtin_bit_cast(float, ub);
        int c = 0;
        for (int J = 0; J < nJ; ++J) { const f32x4 x = ldrow(rowp, J, lane, t);
#pragma unroll
            for (int e = 0; e < 4; ++e) if (x[e] != -INFINITY) c += (bin_of(x[e], nls, scale) == Tb && x[e] > tau) ? 1 : 0; }
        cgt = wave_isum(c); }
    const int req = 256 - (above + cgt);
    base = 0; int taken = 0;
    for (int J = 0; J < nJ; ++J) {
        const f32x4 x = ldrow(rowp, J, lane, t);
        unsigned long long em[4]; int ebef = 0, ecnt = 0;
#pragma unroll
        for (int e = 0; e < 4; ++e) { em[e] = __ballot(x[e] == tau); ebef += mbcnt64(em[e]); ecnt += __builtin_popcountll(em[e]); }
        bool sel[4]; int own = 0;
#pragma unroll
        for (int e = 0; e < 4; ++e) { const bool eq = x[e] == tau; sel[e] = x[e] > tau || (eq && taken + ebef + own < req); own += eq ? 1 : 0; }
        unsigned long long sm[4]; int sbef = 0, scnt = 0;
#pragma unroll
        for (int e = 0; e < 4; ++e) { sm[e] = __ballot(sel[e]); sbef += mbcnt64(sm[e]); scnt += __builtin_popcountll(sm[e]); }
        int pos = base + sbef;
#pragma unroll
        for (int e = 0; e < 4; ++e) if (sel[e]) { list[pos] = 256 * J + 4 * lane + e; ++pos; }
        base += scnt; taken += ecnt;
    }
    enc_list(list, t, lut, lane);
    return 256;
}

__device__ __forceinline__ void phase(LAS unsigned char* lds, const bf16* PO, const float* TO, const unsigned char* C8, const bf16* WUKT, const unsigned char* WUVT8, const float* t5, unsigned char* scratch, bf16* OMIX) {
    const int tid = threadIdx.x, lane = tid & 63, l15_ = lane & 15, g_ = lane >> 4; const int wid = __builtin_amdgcn_readfirstlane(tid >> 6);
    const int bx = blockIdx.x, G = gridDim.x; const int vcu = (G % 8 == 0) ? (bx % 8) * (G / 8) + bx / 8 : bx;
    LAS float* t5l = (LAS float*)(lds + L_T5); LAS unsigned char* lut = lds + L_LUT;
    LAS unsigned char* wl = lds + L_WAVE + wid * WAVE_LDS;
    LAS unsigned* hist = (LAS unsigned*)(wl + W_HIST); LAS int* list0 = (LAS int*)(wl + W_LIST); LAS float* cand = (LAS float*)(wl + W_CAND);
    unsigned char* scr = scratch + (size_t)bx * SCR_BYTES;
    unsigned char* QL = scr + SCR_QL; unsigned char* OL = scr + SCR_OL;
    t5l[tid] = t5[tid] * L2E;
    if (tid < 16) t5l[512 + tid] = -INFINITY;
    if (tid < 128) lut[tid] = (unsigned char)t5_bucket(tid);
    __syncthreads();
    for (int v = vcu; v < 256; v += G) {
        const int b = v >> 5, jj = v & 31;
#pragma unroll 1
        for (int tg = 0; tg < 2; ++tg) {
#define DSA_TQ(s) (64 * (2 * tg + ((s) >> 1)) + (((s) & 1) ? 63 - jj : jj))
            const size_t mb0 = (size_t)b * SEQ;
#pragma unroll 1
            for (int hq = 0; hq < 2; ++hq) { const int hh = 2 * wid + hq;
                int l15 = l15_, g = g_; asm volatile("" : "+v"(l15), "+v"(g));
                bf16x8 bq[4][2];
#pragma unroll
                for (int sub = 0; sub < 4; ++sub)
#pragma unroll
                    for (int ks = 0; ks < 2; ++ks) bq[sub][ks] = *(const bf16x8*)(PO + (mb0 + 16 * DSA_TQ(sub) + l15) * NO_IN + hh * 64 + 32 * ks + 8 * g);
                const bf16* wp0 = WUKT + ((size_t)(hh * 256 + l15)) * 64 + 8 * g;
#pragma unroll 1
                for (int lh = 0; lh < 2; ++lh) {
                    bf16x8 wa[8][2];
#pragma unroll
                    for (int k = 0; k < 8; ++k) { const bf16* wp = wp0 + (size_t)(16 * (8 * lh + k)) * 64; wa[k][0] = *(const bf16x8*)wp; wa[k][1] = *(const bf16x8*)(wp + 32); }
#pragma unroll
                    for (int sub = 0; sub < 4; ++sub)
#pragma unroll
                        for (int k = 0; k < 8; ++k) { const int lt = 8 * lh + k;
                            f32x4 acc = {0.f, 0.f, 0.f, 0.f};
                            acc = __builtin_amdgcn_mfma_f32_16x16x32_bf16(wa[k][0], bq[sub][0], acc, 0, 0, 0);
                            acc = __builtin_amdgcn_mfma_f32_16x16x32_bf16(wa[k][1], bq[sub][1], acc, 0, 0, 0);
                            { int p8 = __builtin_amdgcn_cvt_pk_fp8_f32(acc[0], acc[1], 0, false); p8 = __builtin_amdgcn_cvt_pk_fp8_f32(acc[2], acc[3], p8, true);
                                *(int*)(QL + sub * 65536 + ((size_t)((hh * 16 + lt) * 16 + l15)) * 16 + 4 * g) = p8; } }
                } }
#pragma unroll 1
            for (int sub = 0; sub < 4; ++sub) {
            const int tq = DSA_TQ(sub); const int t0 = tq * 16; const size_t m0 = mb0 + t0; const unsigned char* QLt = QL + sub * 65536; unsigned char* OLt = OL + sub * 65536;
            {
                int l15 = l15_, g = g_; asm volatile("" : "+v"(l15), "+v"(g));
                typedef float sf32x2 __attribute__((ext_vector_type(2))); typedef _Float16 sf16x2 __attribute__((ext_vector_type(2)));
                bf16x8 aq[8][2]; sf32x2 wq[4][4];
#pragma unroll
                for (int hh = 0; hh < 8; ++hh)
#pragma unroll
                    for (int ks = 0; ks < 2; ++ks) aq[hh][ks] = *(const bf16x8*)(PO + (m0 + l15) * NO_IN + 1280 + hh * 64 + 32 * ks + 8 * g);
#pragma unroll
                for (int i = 0; i < 4; ++i)
#pragma unroll
                    for (int hp = 0; hp < 4; ++hp) { const sf32x2 w2 = *(const sf32x2*)(TO + (m0 + 4 * g + i) * 32 + 2 * hp); wq[i][hp] = w2 * (0.35355339059327373f * 0.125f); }
                const bf16* kp0 = PO + (mb0 + l15) * NO_IN + 1800 + 8 * g;
                bf16x8 na0 = (bf16x8){0, 0, 0, 0, 0, 0, 0, 0}, na1 = na0, nb0 = na0, nb1 = na0, nc0 = na0, nc1 = na0;
                if (wid <= tq) { const bf16* kp = kp0 + (size_t)(16 * wid) * NO_IN; na0 = *(const bf16x8*)kp; na1 = *(const bf16x8*)(kp + 32); }
                if (wid + 8 <= tq) { const bf16* kp = kp0 + (size_t)(16 * (wid + 8)) * NO_IN; nb0 = *(const bf16x8*)kp; nb1 = *(const bf16x8*)(kp + 32); }
                if (wid + 16 <= tq) { const bf16* kp = kp0 + (size_t)(16 * (wid + 16)) * NO_IN; nc0 = *(const bf16x8*)kp; nc1 = *(const bf16x8*)(kp + 32); }
                sf16x2 rlo2[2], rhi2[2];
                rlo2[0] = rlo2[1] = (sf16x2){(_Float16)INFINITY, (_Float16)INFINITY}; rhi2[0] = rhi2[1] = (sf16x2){(_Float16)(-INFINITY), (_Float16)(-INFINITY)};
#define DSA_SCORE_STEP(n0, n1, ktv) do { const int kt_ = (ktv); const bf16x8 bk0 = n0, bk1 = n1; \
                    if (kt_ + 24 <= tq) { const bf16* kp = kp0 + (size_t)(16 * (kt_ + 24)) * NO_IN; n0 = *(const bf16x8*)kp; n1 = *(const bf16x8*)(kp + 32); } \
                    sf32x2 sc2[4]; \
                    _Pragma("unroll") for (int i = 0; i < 4; ++i) sc2[i] = (sf32x2){0.f, 0.f}; \
                    _Pragma("unroll") for (int hp = 0; hp < 4; ++hp) { \
                        f32x4 accA = {0.f, 0.f, 0.f, 0.f}, accB = {0.f, 0.f, 0.f, 0.f}; \
                        accA = __builtin_amdgcn_mfma_f32_16x16x32_bf16(aq[2 * hp][0], bk0, accA, 0, 0, 0); \
                        accB = __builtin_amdgcn_mfma_f32_16x16x32_bf16(aq[2 * hp + 1][0], bk0, accB, 0, 0, 0); \
                        accA = __builtin_amdgcn_mfma_f32_16x16x32_bf16(aq[2 * hp][1], bk1, accA, 0, 0, 0); \
                        accB = __builtin_amdgcn_mfma_f32_16x16x32_bf16(aq[2 * hp + 1][1], bk1, accB, 0, 0, 0); \
                        _Pragma("unroll") for (int i = 0; i < 4; ++i) { const sf32x2 r2 = {relu_bits(accA[i]), relu_bits(accB[i])}; sc2[i] = wq[i][hp] * r2 + sc2[i]; } } \
                    _Pragma("unroll") for (int ip = 0; ip < 2; ++ip) { \
                        const sf16x2 h2 = {(_Float16)(sc2[2 * ip][0] + sc2[2 * ip][1]), (_Float16)(sc2[2 * ip + 1][0] + sc2[2 * ip + 1][1])}; \
                        rlo2[ip] = __builtin_elementwise_min(rlo2[ip], h2); rhi2[ip] = __builtin_elementwise_max(rhi2[ip], h2); \
                        _Pragma("unroll") for (int j = 0; j < 2; ++j) { const int q = 4 * g + 2 * ip + j; \
                            *(LAS _Float16*)(lds + L_WAVE + (q >> 1) * WAVE_LDS + (q & 1) * W_ROW + (16 * kt_ + l15) * 2) = h2[j]; } }     \
                } while (0)
                for (int kt = wid; kt <= tq; kt += 24) {
                    DSA_SCORE_STEP(na0, na1, kt);
                    if (kt + 8 <= tq) DSA_SCORE_STEP(nb0, nb1, kt + 8);
                    if (kt + 16 <= tq) DSA_SCORE_STEP(nc0, nc1, kt + 16);
                }
#undef DSA_SCORE_STEP
                float rlo[4], rhi[4];
#pragma unroll
                for (int i = 0; i < 4; ++i) { rlo[i] = (float)rlo2[i >> 1][i & 1]; rhi[i] = (float)rhi2[i >> 1][i & 1]; }
#pragma unroll
                for (int i = 0; i < 4; ++i) {
#pragma unroll
                    for (int o = 1; o < 16; o <<= 1) { rlo[i] = fminf(rlo[i], __shfl_xor(rlo[i], o)); rhi[i] = fmaxf(rhi[i], __shfl_xor(rhi[i], o)); }
                    if (l15 == 0) { LAS float* mm = (LAS float*)(lds + L_MM) + (wid * 16 + 4 * g + i) * 2; mm[0] = rlo[i]; mm[1] = rhi[i]; } }
            }
            __syncthreads();
            int nsel0, nsel1;
            { int lnv = lane; asm volatile("" : "+v"(lnv));
                const LAS float* mm = (const LAS float*)(lds + L_MM);
                float lo0 = INFINITY, hi0 = -INFINITY, lo1 = INFINITY, hi1 = -INFINITY;
#pragma unroll
                for (int w = 0; w < 8; ++w) { const f32x4 m4 = *(const LAS f32x4*)(mm + (w * 16 + 2 * wid) * 2); lo0 = fminf(lo0, m4.x); hi0 = fmaxf(hi0, m4.y); lo1 = fminf(lo1, m4.z); hi1 = fmaxf(hi1, m4.w); }
                nsel0 = select_row(wl, t0 + 2 * wid, lo0, hi0, list0, hist, (LAS unsigned*)cand, lut, lnv);
                nsel1 = select_row(wl + W_ROW, t0 + 2 * wid + 1, lo1, hi1, list0 + 256, hist, (LAS unsigned*)cand, lut, lnv); }
            {
                int l15 = l15_, g = g_, lnv = lane; asm volatile("" : "+v"(l15), "+v"(g), "+v"(lnv));
                const int nch0 = (nsel0 + 31) >> 5, nch1 = (nsel1 + 31) >> 5;
                const char* Cb = (const char*)(C8 + mb0 * 256);
                const int pl = ((l15 & 3) << 2) | (l15 >> 2);
                const int rw_x = (g >> 1) ^ pl;
                const int rbase = pl * 256 + 8 * (g & 1);
                const int q8 = l15 >> 1, p2 = lnv & 1; const int tR = q8 < 4 ? 4 * q8 + g : 16 + 4 * (q8 - 4) + g;
                const int t_x = (tR & 15) ^ ((tR >> 4) << 1); const int tbase = tR * 256 + 8 * p2;
                const unsigned wlb = (unsigned)(size_t)wl;
#define DSA_IDS(lst, cc, dst) do { dst[0] = *(const LAS v4u*)((lst) + 32 * (cc) + 4 * g); dst[1] = *(const LAS v4u*)((lst) + 32 * (cc) + 16 + 4 * g); } while (0)
#define DSA_GATHER(idv, bufoff) do { \
                    _Pragma("unroll") for (int i_ = 0; i_ < 8; ++i_) { const int r_ = 4 * i_ + g; const unsigned e_ = idv[i_ >> 2][i_ & 3]; \
                        const unsigned off_ = (e_ & 0xffffff00u) + (unsigned)((((lnv & 15) ^ (r_ & 15) ^ ((r_ >> 4) << 1))) << 4); \
                        __builtin_amdgcn_global_load_lds((const unsigned*)(Cb + off_), (LAS unsigned*)(wl + (bufoff) + i_ * 1024), 16, 0, 0); } } while (0)
                long qf[8], qn[8];
#pragma unroll
                for (int ks = 0; ks < 8; ++ks) qf[ks] = *(const long*)(QLt + ((size_t)((l15 * 16 + 2 * ks + (g >> 1)) * 16 + 2 * wid)) * 16 + (g & 1) * 8);
#pragma unroll
                for (int ks = 0; ks < 8; ++ks) qn[ks] = *(const long*)(QLt + ((size_t)((l15 * 16 + 2 * ks + (g >> 1)) * 16 + 2 * wid + 1)) * 16 + (g & 1) * 8);
                v4u idn[2];
                asm volatile("s_waitcnt lgkmcnt(0)" ::: "memory");
                DSA_IDS(list0, 0, idn); DSA_GATHER(idn, 0);
                f32x4 o[16];
#pragma unroll
                for (int nt = 0; nt < 16; ++nt) o[nt] = (f32x4){0.f, 0.f, 0.f, 0.f};
                float mrun = -INFINITY, lsum = 0.f;
                int rq = 0, c = 0, nch = nch0; LAS int* list = list0; bool done = false;
#define DSA_CHUNK(BO) do { \
                    v4u idc[2]; idc[0] = idn[0]; idc[1] = idn[1]; \
                    bool more = true; \
                    if (c + 1 < nch) { DSA_IDS(list, c + 1, idn); DSA_GATHER(idn, 8192 - (BO)); } \
                    else if (rq == 0) { DSA_IDS(list0 + 256, 0, idn); DSA_GATHER(idn, 8192 - (BO)); } \
                    else more = false; \
                      \
                    float bs[2][4]; \
                    _Pragma("unroll") for (int kt = 0; kt < 2; ++kt) \
                        _Pragma("unroll") for (int i = 0; i < 4; ++i) bs[kt][i] = t5l[(idc[kt][i] & 0xffu) * 16 + l15]; \
                    if (more) asm volatile("s_waitcnt vmcnt(8)" ::: "memory");       \
                    else asm volatile("s_waitcnt vmcnt(0)" ::: "memory"); \
                    f32x4 st[2]; \
                    _Pragma("unroll") for (int kt = 0; kt < 2; ++kt) { f32x4 acc = {0.f, 0.f, 0.f, 0.f}; \
                        _Pragma("unroll") for (int ks = 0; ks < 8; ++ks) { const long a8 = *(const LAS long*)(wl + (BO) + kt * 4096 + rbase + ((((2 * ks) ^ (2 * kt)) ^ rw_x) << 4)); acc = __builtin_amdgcn_mfma_f32_16x16x32_fp8_fp8(a8, qf[ks], acc, 0, 0, 0); } \
                        st[kt] = acc; } \
                    float lm = -INFINITY; \
                    _Pragma("unroll") for (int kt = 0; kt < 2; ++kt) \
                        _Pragma("unroll") for (int i = 0; i < 4; ++i) { const float s = st[kt][i] * (0.125f * L2E) + bs[kt][i]; st[kt][i] = s; lm = fmaxf(lm, s); } \
                      \
                    if (__any(lm > mrun + 6.0f)) { \
                        float cm = fmaxf(lm, __shfl_xor(lm, 16)); cm = fmaxf(cm, __shfl_xor(cm, 32)); \
                        const float mnew = fmaxf(mrun, cm), alpha = __builtin_amdgcn_exp2f(mrun - mnew); mrun = mnew; \
                        lsum *= alpha; \
                        if (__any(alpha != 1.0f)) { \
                            _Pragma("unroll") for (int nt = 0; nt < 16; ++nt) o[nt] *= alpha; \
                        } \
                    } \
                    float ps = 0.f; \
                    _Pragma("unroll") for (int kt = 0; kt < 2; ++kt) \
                        _Pragma("unroll") for (int i = 0; i < 4; ++i) { st[kt][i] = __builtin_amdgcn_exp2f(st[kt][i] - mrun); ps += st[kt][i]; } \
                    lsum += ps; \
                    int plo = __builtin_amdgcn_cvt_pk_fp8_f32(st[0][0], st[0][1], 0, false); plo = __builtin_amdgcn_cvt_pk_fp8_f32(st[0][2], st[0][3], plo, true); \
                    int phi = __builtin_amdgcn_cvt_pk_fp8_f32(st[1][0], st[1][1], 0, false); phi = __builtin_amdgcn_cvt_pk_fp8_f32(st[1][2], st[1][3], phi, true); \
                    const long pb = (long)(((unsigned long long)(unsigned)phi << 32) | (unsigned)plo); \
                    long a8[16]; \
                    _Pragma("unroll") for (int nt = 0; nt < 16; ++nt) { const unsigned ad = wlb + tbase + (((nt ^ t_x)) << 4); \
                        asm volatile("ds_read_b64_tr_b8 %0, %1 offset:%2" : "=&v"(a8[nt]) : "v"(ad), "n"(BO) : "memory"); } \
                    asm volatile("s_waitcnt lgkmcnt(0)" ::: "memory"); __builtin_amdgcn_sched_barrier(0); \
                    _Pragma("unroll") for (int nt = 0; nt < 16; ++nt) o[nt] = __builtin_amdgcn_mfma_f32_16x16x32_fp8_fp8(a8[nt], pb, o[nt], 0, 0, 0); \
                    if (++c == nch) {                                        \
                        lsum += __shfl_xor(lsum, 16); lsum += __shfl_xor(lsum, 32); \
                        const float inv = 1.f / lsum; const int rw = 2 * wid + rq; \
                        _Pragma("unroll") for (int nt = 0; nt < 16; ++nt) { const f32x4 y = o[nt] * (inv * 16.0f);            \
                            int p8 = __builtin_amdgcn_cvt_pk_fp8_f32(y[0], y[1], 0, false); p8 = __builtin_amdgcn_cvt_pk_fp8_f32(y[2], y[3], p8, true); \
                            *(int*)(OLt + ((size_t)((rw * 16 + nt) * 16 + l15)) * 16 + 4 * g) = p8; } \
                        if (rq == 1) done = true; \
                        else { rq = 1; c = 0; nch = nch1; list = list0 + 256; mrun = -INFINITY; lsum = 0.f; \
                            _Pragma("unroll") for (int ks = 0; ks < 8; ++ks) qf[ks] = qn[ks]; \
                            _Pragma("unroll") for (int nt = 0; nt < 16; ++nt) o[nt] = (f32x4){0.f, 0.f, 0.f, 0.f}; } \
                    } } while (0)
                for (;;) {
                    DSA_CHUNK(0);
                    if (done) break;
                    DSA_CHUNK(8192);
                    if (done) break;
                }
#undef DSA_CHUNK
#undef DSA_GATHER
#undef DSA_IDS
            }
            __syncthreads();
            }
#pragma unroll 1
            for (int hq = 0; hq < 2; ++hq) { const int hh = 2 * wid + hq;
                int l15 = l15_, g = g_; asm volatile("" : "+v"(l15), "+v"(g));
                long ol[4][8];
#pragma unroll
                for (int sub = 0; sub < 4; ++sub)
#pragma unroll
                    for (int ks = 0; ks < 8; ++ks) ol[sub][ks] = *(const long*)(OL + sub * 65536 + ((size_t)((l15 * 16 + 2 * ks + (g >> 1)) * 16 + hh)) * 16 + (g & 1) * 8);
#pragma unroll 1
                for (int dt = 0; dt < 4; ++dt) {
                    const unsigned char* wp = WUVT8 + ((size_t)(hh * 64 + 16 * dt + l15)) * 256 + 8 * g;
                    long wv[8];
#pragma unroll
                    for (int ks = 0; ks < 8; ++ks) wv[ks] = *(const long*)(wp + 32 * ks);
#pragma unroll
                    for (int sub = 0; sub < 4; ++sub) { f32x4 acc = {0.f, 0.f, 0.f, 0.f};
#pragma unroll
                        for (int ks = 0; ks < 8; ++ks) acc = __builtin_amdgcn_mfma_f32_16x16x32_fp8_fp8(wv[ks], ol[sub][ks], acc, 0, 0, 0);
                        acc *= (1.0f / 1024.0f);
                        *(unsigned long long*)(OMIX + (mb0 + 16 * DSA_TQ(sub) + l15) * DM + hh * 64 + 16 * dt + 4 * g) = (unsigned long long)pg8::cvt_pk_bf16(acc[0], acc[1]) | ((unsigned long long)pg8::cvt_pk_bf16(acc[2], acc[3]) << 32); }
                } }
            __syncthreads();
#undef DSA_TQ
        }
    }
}
__device__ __forceinline__ void cnorm_phase(const bf16* PO, const float* gk, unsigned char* C8) {
    const int lane = threadIdx.x & 63, gw = blockIdx.x * 8 + (threadIdx.x >> 6), NGW = gridDim.x * 8;
    const f32x4 gv = *(const f32x4*)(gk + lane * 4);
    for (int m = gw; m < M; m += NGW) {
        const unsigned long long raw = *(const unsigned long long*)(PO + (size_t)m * NO_IN + 1024 + lane * 4);
        const float x0 = bf2f((unsigned short)raw), x1 = bf2f((unsigned short)(raw >> 16)), x2 = bf2f((unsigned short)(raw >> 32)), x3 = bf2f((unsigned short)(raw >> 48));
        const float rstd = rsqrtf(wave_sum(x0 * x0 + x1 * x1 + x2 * x2 + x3 * x3) * (1.f / 256.f) + EPS);
        int p8 = __builtin_amdgcn_cvt_pk_fp8_f32(x0 * rstd * gv.x, x1 * rstd * gv.y, 0, false); p8 = __builtin_amdgcn_cvt_pk_fp8_f32(x2 * rstd * gv.z, x3 * rstd * gv.w, p8, true);
        *(int*)(C8 + (size_t)m * 256 + lane * 4) = p8;
    }
}
}
__device__ __forceinline__ void xb_phase(const float* X, bf16* XB, float* SSQ) {
    const int lane = threadIdx.x & 63, gw = blockIdx.x * 8 + (threadIdx.x >> 6), NGW = gridDim.x * 8;
    for (int m = gw; m < M; m += NGW) {
        const f32x4* xr = (const f32x4*)(X + (size_t)m * DM) + lane;
        f32x4 v[4]; float s = 0.f;
#pragma unroll
        for (int j = 0; j < 4; ++j) { v[j] = xr[64 * j]; s += (v[j].x * v[j].x + v[j].y * v[j].y) + (v[j].z * v[j].z + v[j].w * v[j].w); }
        s = wave_sum(s);
        unsigned long long* o8 = (unsigned long long*)(XB + (size_t)m * DM) + lane;
#pragma unroll
        for (int j = 0; j < 4; ++j) o8[64 * j] = (unsigned long long)pk2(v[j].x, v[j].y) | ((unsigned long long)pk2(v[j].z, v[j].w) << 32);
        if (lane < 16) SSQ[(size_t)m * 16 + lane] = lane == 0 ? s : 0.f;
    }
}
__device__ __forceinline__ void final_norm_phase(const bf16* XB, const float* g, float* out) {
    const int lane = threadIdx.x & 63, gw = blockIdx.x * 8 + (threadIdx.x >> 6), NGW = gridDim.x * 8;
    f32x4 gv[4];
#pragma unroll
    for (int j = 0; j < 2; ++j) { gv[2 * j] = *(const f32x4*)(g + 512 * j + 8 * lane); gv[2 * j + 1] = *(const f32x4*)(g + 512 * j + 8 * lane + 4); }
    for (int m0 = gw * 4; m0 < M; m0 += NGW * 4) {
        v4u raw[4][2];
#pragma unroll
        for (int r = 0; r < 4; ++r)
#pragma unroll
            for (int j = 0; j < 2; ++j) raw[r][j] = *(const v4u*)(XB + (size_t)(m0 + r) * DM + 512 * j + 8 * lane);
#pragma unroll
        for (int r = 0; r < 4; ++r) { f32x4 v[4]; float s = 0.f;
#pragma unroll
            for (int j = 0; j < 2; ++j) { const v4u w = raw[r][j];
                v[2 * j] = (f32x4){__builtin_bit_cast(float, w.x << 16), __builtin_bit_cast(float, w.x & 0xffff0000u), __builtin_bit_cast(float, w.y << 16), __builtin_bit_cast(float, w.y & 0xffff0000u)};
                v[2 * j + 1] = (f32x4){__builtin_bit_cast(float, w.z << 16), __builtin_bit_cast(float, w.z & 0xffff0000u), __builtin_bit_cast(float, w.w << 16), __builtin_bit_cast(float, w.w & 0xffff0000u)}; }
#pragma unroll
            for (int j = 0; j < 4; ++j) s += (v[j].x * v[j].x + v[j].y * v[j].y) + (v[j].z * v[j].z + v[j].w * v[j].w);
            const float rstd = rsqrtf(wave_sum(s) * (1.f / DM) + EPS);
            float* o = out + (size_t)(m0 + r) * DM + 8 * lane;
            *(f32x4*)o = v[0] * rstd * gv[0]; *(f32x4*)(o + 4) = v[1] * rstd * gv[1]; *(f32x4*)(o + 512) = v[2] * rstd * gv[2]; *(f32x4*)(o + 516) = v[3] * rstd * gv[3]; }
    }
}

#define RLX_AGENT __ATOMIC_RELAXED, __HIP_MEMORY_SCOPE_AGENT
typedef GAS unsigned gu32;
#define XB_TMO      128
#define XB_XCNT(j)  (256  + 64 * (j))
#define XB_XSUB(j)  (1280 + 64 * (j))
#define XB_XGEN(j)  (2304 + 64 * (j))
#define XB_TOP      3328
#define XB_TOPGEN   3392
#define XCD_BAR_WORDS 3456
#define XB_SPIN_CAP (1u << 18)

__device__ __forceinline__ unsigned xb_ld(unsigned* p)              { return __hip_atomic_load(p, __ATOMIC_RELAXED, __HIP_MEMORY_SCOPE_AGENT); }
__device__ __forceinline__ unsigned xb_add(unsigned* p, unsigned v) { return __hip_atomic_fetch_add(p, v, __ATOMIC_RELAXED, __HIP_MEMORY_SCOPE_AGENT); }
__device__ __forceinline__ unsigned xb_xcc_id() { return (unsigned)__builtin_amdgcn_s_getreg((3 << 11) | 20) & 0xFu; }
#define XB_SPIN(cond, bar) do { unsigned _sp = 0; while (cond) { __builtin_amdgcn_s_sleep(1); \
    if ((++_sp & 255u) == 0u) { if (xb_ld(&(bar)[XB_TMO])) break; if (_sp > XB_SPIN_CAP) { atomicAdd(&(bar)[XB_TMO], 1u); break; } } } } while (0)

struct XcdBarrier {
    unsigned* bar; unsigned x;
    volatile LAS unsigned* st;
};

__device__ __forceinline__ XcdBarrier xcd_barrier_post(unsigned* bar, volatile LAS unsigned* st) {
    XcdBarrier b; b.bar = bar; b.x = xb_xcc_id(); b.st = st;
    if (threadIdx.x == 0) (void)xb_add(&bar[XB_XCNT(b.x)], 1u);
    return b;
}
__device__ __forceinline__ void xcd_barrier_complete(unsigned* bar, unsigned x, unsigned& nloc, unsigned& nx) {
    const unsigned G = gridDim.x * gridDim.y * gridDim.z;
    unsigned sum, cnt, mine, sp = 0u;
    for (;;) {
        sum = 0u; cnt = 0u; mine = 0u;
#pragma unroll
        for (unsigned j = 0; j < 16; ++j) { const unsigned c = xb_ld(&bar[XB_XCNT(j)]); sum += c; cnt += (c > 0u) ? 1u : 0u; mine = (j == x) ? c : mine; }
        if (sum == G) break;
        __builtin_amdgcn_s_sleep(1);
        if ((++sp & 255u) == 0u) { if (xb_ld(&bar[XB_TMO])) break; if (sp > XB_SPIN_CAP) { atomicAdd(&bar[XB_TMO], 1u); break; } }
    }
    nloc = mine > 0u ? mine : 1u; nx = cnt > 0u ? cnt : 1u;
}

__device__ __forceinline__ void xcd_barrier(const XcdBarrier& b) {
    asm volatile("s_waitcnt vmcnt(0)" ::: "memory");
    __syncthreads();
    if (threadIdx.x == 0) {
        unsigned* bar = b.bar;
        __builtin_amdgcn_s_waitcnt(0);
        unsigned nloc = b.st[0], nx = b.st[1];
        if (nloc == 0u) { xcd_barrier_complete(bar, b.x, nloc, nx); b.st[0] = nloc; b.st[1] = nx; }
        const unsigned old = xb_add(&bar[XB_XSUB(b.x)], 1u);
        const unsigned gen = old / nloc;
        if (old + 1u == (gen + 1u) * nloc) {
            __builtin_amdgcn_fence(__ATOMIC_RELEASE, "agent");
            asm volatile("s_waitcnt vmcnt(0)" ::: "memory");
            const unsigned og = xb_add(&bar[XB_TOP], 1u);
            const unsigned tg = og / nx;
            if (og + 1u == (tg + 1u) * nx) xb_add(&bar[XB_TOPGEN], 1u);
            else XB_SPIN(xb_ld(&bar[XB_TOPGEN]) == tg, bar);
            __builtin_amdgcn_fence(__ATOMIC_ACQUIRE, "agent");
            xb_add(&bar[XB_XGEN(b.x)], 1u);
            asm volatile("s_waitcnt vmcnt(0)" ::: "memory");
        } else {
            XB_SPIN(xb_ld(&bar[XB_XGEN(b.x)]) == gen, bar);
            __builtin_amdgcn_fence(__ATOMIC_ACQUIRE, "agent");
            asm volatile("s_waitcnt vmcnt(0)" ::: "memory");
        }
    }
    __syncthreads();
}


constexpr int NPHASE = 19;
constexpr int LDS_TOTAL = 163840, MISC_OFF = 163840 - 256;
static_assert(dsa::LDS_BYTES <= MISC_OFF && gla::LDS_BYTES <= MISC_OFF && fox::LDS_BYTES <= MISC_OFF, "LDS map");
constexpr int CW_BAR = 4096;
struct Args {
    const float* x; const float* norm_g; const float* ffn_w_in; const float* ffn_w_out; const float* even_w_in; const float* gla_w_gate; const float* gla_b_gate; const float* gla_norm_g;
    const float* fox_b_f; const float* even_w_out; const float* odd_w_in; const float* kv_norm_g; const float* w_uk; const float* w_uv; const float* odd_w_out; const float* t5; const float* final_g;
    float* out; unsigned char* ws; int ph_lo, ph_hi;
};
__device__ __forceinline__ void prologue_phase(LAS unsigned char* lds, const Args& a) {
    const int lane = threadIdx.x & 63, wave = threadIdx.x >> 6;
    LAS float* scr = (LAS float*)lds + wave * 64 * 33;
    const int gw = blockIdx.x * 8 + wave, NGW = gridDim.x * 8;
    unsigned char* ws = a.ws;
    constexpr int N_FI = (2 * DFF / 32) * (DM / 64), N_FO = (DM / 32) * (DFF / 64), N_EI = (NE_IN / 32) * (DM / 64), N_SQ = (DM / 32) * (DM / 64), N_OI = (NO_IN / 32) * (DM / 64), N_UK = 256 / 32;
    constexpr int O_FO = 4 * N_FI, O_EI = O_FO + 4 * N_FO, O_EO = O_EI + N_EI, O_OI = O_EO + N_SQ, O_OO = O_OI + N_OI, O_UK = O_OO + N_SQ, N_ALL = O_UK + 16 * N_UK;
#pragma unroll 1
    for (int I = gw; I < N_ALL; I += NGW) {
        int i, it;
        if (I < O_FO) { i = I / N_FI; it = I - i * N_FI; }
        else if (I < O_EI) { const int q = (I - O_FO) / N_FO; i = 4 + q; it = (I - O_FO) - q * N_FO; }
        else if (I < O_EO) { i = 8; it = I - O_EI; }
        else if (I < O_OI) { i = 9; it = I - O_EO; }
        else if (I < O_OO) { i = 10; it = I - O_OI; }
        else if (I < O_UK) { i = 11; it = I - O_OO; }
        else { i = 12 + ((I - O_UK) >> 3); it = (I - O_UK) & 7; }
        WDesc w;
        if (i < 4) w = WDesc{a.ffn_w_in + (size_t)i * DM * 2 * DFF, (bf16*)(ws + WS_WFI + i * FI_BYTES), a.norm_g + (i == 0 ? 0 : i == 1 ? 2 : i == 2 ? 3 : 5) * DM, DM, 2 * DFF, 2 * DFF, 1};
        else if (i < 8) w = WDesc{a.ffn_w_out + (size_t)(i - 4) * DFF * DM, (bf16*)(ws + WS_WFO + (i - 4) * FO_BYTES), nullptr, DFF, DM, DM, 0};
        else if (i == 8) w = WDesc{a.even_w_in, (bf16*)(ws + WS_WEI), a.norm_g + 1 * DM, DM, 3096, NE_IN, 2};
        else if (i == 9) w = WDesc{a.even_w_out, (bf16*)(ws + WS_WEO), nullptr, DM, DM, DM, 0};
        else if (i == 10) w = WDesc{a.odd_w_in, (bf16*)(ws + WS_WOI), a.norm_g + 4 * DM, DM, 1864, NO_IN, 3};
        else if (i == 11) w = WDesc{a.odd_w_out, (bf16*)(ws + WS_WOO), nullptr, DM, DM, DM, 0};
        else w = WDesc{a.w_uk + (size_t)(i - 12) * 64 * 256, (bf16*)(ws + WS_WUK) + (size_t)(i - 12) * 256 * 64, nullptr, 64, 256, 256, 0};
        transpose_item(w, scr, it, lane);
    }
    for (int e4 = blockIdx.x * 512 + threadIdx.x; e4 < 16 * 64 * 64; e4 += gridDim.x * 512) { const int l4 = e4 & 63, d = (e4 >> 6) & 63, hh = e4 >> 12;
        const float* s = a.w_uv + ((size_t)hh * 256 + 4 * l4) * 64 + d;
        int p8 = __builtin_amdgcn_cvt_pk_fp8_f32(s[0] * 64.f, s[64] * 64.f, 0, false); p8 = __builtin_amdgcn_cvt_pk_fp8_f32(s[128] * 64.f, s[192] * 64.f, p8, true);
        *(int*)(ws + WS_WUV + ((size_t)(hh * 64 + d)) * 256 + 4 * l4) = p8; }
}
template <class Epi> __device__ __forceinline__ void gemm_call_norm(LAS unsigned char* lds, const bf16* A, const bf16* Bt, int N, int K, const Epi& E, const float* SSQ) {
    pg8::StaticOrder S; S.init(M, N, (int)gridDim.x, (int)blockIdx.x);
    LAS float* tab = (LAS float*)(lds + pg8::RSTD_LDS_OFF);
    LAS int* pml = (LAS int*)(lds + pg8::RSTD_LDS_OFF + 16384);
    pg8::Unit u; int nu = 0;
    for (; S.next(nu, u) && nu < 16; ++nu) { if (threadIdx.x == 0) pml[nu] = u.pm; }
    __syncthreads();
    f32x4 pv[8][4];
#pragma unroll
    for (int j = 0; j < 8; ++j) { const int idx = threadIdx.x + 512 * j; if (idx < nu * 256) { const int row = pml[idx >> 8] * 256 + (idx & 255); const f32x4* p = (const f32x4*)(SSQ + (size_t)row * 16);
#pragma unroll
            for (int k = 0; k < 4; ++k) pv[j][k] = p[k]; } }
#pragma unroll
    for (int j = 0; j < 8; ++j) { const int idx = threadIdx.x + 512 * j; if (idx < nu * 256) {
            const float s = ((pv[j][0].x + pv[j][0].y) + (pv[j][0].z + pv[j][0].w)) + ((pv[j][1].x + pv[j][1].y) + (pv[j][1].z + pv[j][1].w)) + ((pv[j][2].x + pv[j][2].y) + (pv[j][2].z + pv[j][2].w)) + ((pv[j][3].x + pv[j][3].y) + (pv[j][3].z + pv[j][3].w));
            tab[idx] = rsqrtf(s * (1.f / DM) + EPS); } }
    __syncthreads();
    pg8::Gemm g{A, Bt, M, N, K};
    pg8::gemm_phase<Epi, pg8::StaticOrder, true, true>((PG8_LAS unsigned char*)lds, g, S, E);
}
template <class Epi> __device__ __forceinline__ void gemm_call(LAS unsigned char* lds, const bf16* A, const bf16* Bt, int N, int K, const Epi& E) {
    pg8::Gemm g{A, Bt, M, N, K};
    pg8::StaticOrder S; S.init(M, N, (int)gridDim.x, (int)blockIdx.x);
    pg8::gemm_phase<Epi, pg8::StaticOrder, true, true>((PG8_LAS unsigned char*)lds, g, S, E);
}
__global__ void __launch_bounds__(512, 2) k_mega(Args a) {
    extern __shared__ __attribute__((aligned(16))) unsigned char lds_raw[];
    LAS unsigned char* lds = (LAS unsigned char*)lds_raw;
    volatile LAS unsigned* MISC = (volatile LAS unsigned*)(lds + MISC_OFF);
    for (int u = threadIdx.x; u < (LDS_TOTAL - MISC_OFF) / 4; u += 512) MISC[u] = 0u;
    __syncthreads();
    unsigned char* ws = a.ws;
    XcdBarrier bar = xcd_barrier_post((unsigned*)(ws + WS_CTL) + CW_BAR, MISC + 8);
    const int lo = a.ph_lo, hi = a.ph_hi;
#define IN(k) (lo <= (k) && (k) < hi)
#define SEAM(k) do { if (IN(k) && IN((k) + 1)) xcd_barrier(bar); } while (0)
    float* X = a.out;
    bf16* XB = (bf16*)(ws + WS_HB); bf16* BIG = (bf16*)(ws + WS_BIG); float* TE = (float*)(ws + WS_TE); float* TO = (float*)(ws + WS_TO);
    bf16* OME = (bf16*)(ws + WS_OMIX_EVEN); bf16* OMO = (bf16*)(ws + WS_OMIX_ODD);
    float* F = (float*)(ws + WS_F); float* SSQ = (float*)(ws + WS_SSQ);
#define FFN_BLOCK(k, idx, src) \
    if (IN(k)) { gemm_call_norm(lds, XB, (const bf16*)(ws + WS_WFI + (size_t)(idx) * FI_BYTES), 2 * DFF, DM, pg8::EpiSwiglu{ws}, SSQ); } SEAM(k); \
    if (IN((k) + 1)) { gemm_call(lds, BIG, (const bf16*)(ws + WS_WFO + (size_t)(idx) * FO_BYTES), DM, DFF, pg8::EpiResid{ws, 0.5f}); } SEAM((k) + 1);

    if (IN(0)) { prologue_phase(lds, a); xb_phase(a.x, XB, SSQ); } SEAM(0);
    FFN_BLOCK(1, 0, a.x)
    if (IN(3)) { gemm_call_norm(lds, XB, (const bf16*)(ws + WS_WEI), NE_IN, DM, pg8::EpiProj{ws, NE_BF, 12, 12, WS_TE}, SSQ); } SEAM(3);
    if (IN(4)) { fox::scan_phase(lds, TE, a.fox_b_f, BIG, F, (float*)(ws + WS_KMAX)); gla::g1_phase(lds, BIG, TE, a.gla_w_gate, a.gla_b_gate, (float*)(ws + WS_GU), (float*)(ws + WS_GDEC), OME); } SEAM(4);
    if (IN(5)) { gla::g2_phase((const float*)(ws + WS_GU), (const float*)(ws + WS_GDEC), (bf16*)(ws + WS_GSP)); fox::phase(lds, BIG, F, (const float*)(ws + WS_KMAX), OME); } SEAM(5);
    if (IN(6)) { gla::g3_phase(lds, BIG, TE, a.gla_w_gate, a.gla_b_gate, (const bf16*)(ws + WS_GSP), a.gla_norm_g, OME); } SEAM(6);
    if (IN(7)) { gemm_call(lds, OME, (const bf16*)(ws + WS_WEO), DM, DM, pg8::EpiResid{ws, 1.0f}); } SEAM(7);
    FFN_BLOCK(8, 1, X)
    FFN_BLOCK(10, 2, X)
    if (IN(12)) { gemm_call_norm(lds, XB, (const bf16*)(ws + WS_WOI), NO_IN, DM, pg8::EpiProj{ws, NO_IN, 8, 7, WS_TO}, SSQ); } SEAM(12);
    if (IN(13)) { dsa::cnorm_phase(BIG, a.kv_norm_g, ws + WS_C); } SEAM(13);
    if (IN(14)) { dsa::phase(lds, BIG, TO, ws + WS_C, (const bf16*)(ws + WS_WUK), ws + WS_WUV, a.t5, ws + WS_DSCR, OMO); } SEAM(14);
    if (IN(15)) { gemm_call(lds, OMO, (const bf16*)(ws + WS_WOO), DM, DM, pg8::EpiResid{ws, 1.0f}); } SEAM(15);
    FFN_BLOCK(16, 3, X)
    if (IN(18)) { final_norm_phase(XB, a.final_g, X); }
#undef IN
#undef SEAM
#undef FFN_BLOCK
}

#ifndef MK_PER_PHASE
#define MK_PER_PHASE 0
#endif
extern "C" void kernel_launch(void* const* d_in, const int* in_sizes, int n_in, void* d_out, int out_size, void* d_ws, size_t ws_size, hipStream_t stream) {
    static int grid = 0;
    if (grid == 0) {
        if (n_in != 17 || ws_size < WS_END || out_size != M * DM) { fprintf(stderr, "kernel_launch: unexpected n_in %d / out_size %d / ws_size %zu; nothing launched\n", n_in, out_size, ws_size); grid = -1; return; }
        int dev = 0, cus = 0, per_cu = 0;
        if (hipGetDevice(&dev) != hipSuccess || hipDeviceGetAttribute(&cus, hipDeviceAttributeMultiprocessorCount, dev) != hipSuccess) { fprintf(stderr, "kernel_launch: device query failed\n"); grid = -1; return; }
        if (hipFuncSetAttribute((const void*)k_mega, hipFuncAttributeMaxDynamicSharedMemorySize, LDS_TOTAL) != hipSuccess) { fprintf(stderr, "kernel_launch: hipFuncSetAttribute failed\n"); grid = -1; return; }
        if (hipOccupancyMaxActiveBlocksPerMultiprocessor(&per_cu, (const void*)k_mega, 512, LDS_TOTAL) != hipSuccess || per_cu < 1) fprintf(stderr, "kernel_launch: occupancy query reports %d blocks per CU\n", per_cu);
        (void)hipGetLastError();
        grid = cus < 256 ? cus : 256;
    }
    if (grid < 0) return;
    if (hipMemsetAsync((char*)d_ws + WS_CTL, 0, 1 * MiB, stream) != hipSuccess) { fprintf(stderr, "kernel_launch: memset failed\n"); return; }
    Args a; memset(&a, 0, sizeof(a));
    a.x = (const float*)d_in[0]; a.norm_g = (const float*)d_in[1]; a.ffn_w_in = (const float*)d_in[2]; a.ffn_w_out = (const float*)d_in[3]; a.even_w_in = (const float*)d_in[4];
    a.gla_w_gate = (const float*)d_in[5]; a.gla_b_gate = (const float*)d_in[6]; a.gla_norm_g = (const float*)d_in[7]; a.fox_b_f = (const float*)d_in[8]; a.even_w_out = (const float*)d_in[9];
    a.odd_w_in = (const float*)d_in[10]; a.kv_norm_g = (const float*)d_in[11]; a.w_uk = (const float*)d_in[12]; a.w_uv = (const float*)d_in[13]; a.odd_w_out = (const float*)d_in[14];
    a.t5 = (const float*)d_in[15]; a.final_g = (const float*)d_in[16]; a.out = (float*)d_out; a.ws = (unsigned char*)d_ws;
#if MK_PER_PHASE
    for (int p = 0; p < NPHASE; ++p) { a.ph_lo = p; a.ph_hi = p + 1; hipLaunchKernelGGL(k_mega, dim3(grid), dim3(512), LDS_TOTAL, stream, a); }
#else
    a.ph_lo = 0; a.ph_hi = NPHASE;
    hipLaunchKernelGGL(k_mega, dim3(grid), dim3(512), LDS_TOTAL, stream, a);
#endif
    const hipError_t le = hipPeekAtLastError();
    if (le != hipSuccess) fprintf(stderr, "kernel_launch: launch failed: %s\n", hipGetErrorName(le));
}
```
